# Optimizing an MI355X kernel written in HIP

```python
import math
import jax, jax.numpy as jnp
from jax import lax
import numpy as np

D_MODEL = 1024
BATCH = 16
SEQ = 2048
DEPTH = 2

N_A = DEPTH // 2
N_B = DEPTH - N_A

H_A = 16
NOPE_A = 64
ROPE_A = 32
V_A = 64
Q_LORA = 768
KV_LORA = 256
WIDTH_A = H_A * V_A
QBLOCK = 128

H_B = 16
HD_B = 64
WIDTH_B = H_B * HD_B
MOBA_BLOCK = 256
MOBA_TOPK = 3
QCHUNK = 8

THETA = 10000.0
LN_EPS = 1e-5
RMS_EPS = 1e-6
ALPHA = (2 * DEPTH) ** 0.25
BETA = (8 * DEPTH) ** (-0.25)

kernel_name = "yoco_mla_moba_gated_deepnorm"


def rope_tables(seq, dim):
    inv = THETA ** (-jnp.arange(0, dim, 2, dtype=jnp.float32) / dim)
    ang = jnp.arange(seq, dtype=jnp.float32)[:, None] * inv[None, :]
    ang = jnp.concatenate([ang, ang], axis=-1)
    return jnp.cos(ang), jnp.sin(ang)


def apply_rope(x, cos, sin):
    x1, x2 = jnp.split(x, 2, axis=-1)
    rot = jnp.concatenate([-x2, x1], axis=-1)
    return (x * cos + rot * sin).astype(x.dtype)


def layer_norm(x, g, b):
    xf = x.astype(jnp.float32)
    mu = jnp.mean(xf, axis=-1, keepdims=True)
    var = jnp.mean(jnp.square(xf - mu), axis=-1, keepdims=True)
    return ((xf - mu) * lax.rsqrt(var + LN_EPS) * g + b).astype(x.dtype)


def rms_norm(x, g):
    xf = x.astype(jnp.float32)
    return (xf * lax.rsqrt(jnp.mean(jnp.square(xf), axis=-1, keepdims=True) + RMS_EPS) * g).astype(x.dtype)


def mla_mixer(x, w_in, q_norm, kv_norm, w_uq, w_ukv, w_o, cos, sin):
    B, S, _ = x.shape
    h = x @ w_in
    c_q, c_kv, k_rope, gate = jnp.split(h, [Q_LORA, Q_LORA + KV_LORA, Q_LORA + KV_LORA + ROPE_A], axis=-1)
    q = (rms_norm(c_q, q_norm) @ w_uq).reshape(B, S, H_A, NOPE_A + ROPE_A)
    q_nope = q[..., :NOPE_A]
    q_rope = apply_rope(q[..., NOPE_A:], cos[None, :, None, :], sin[None, :, None, :])
    kv = (rms_norm(c_kv, kv_norm) @ w_ukv).reshape(B, S, H_A, NOPE_A + V_A)
    k_nope, v = kv[..., :NOPE_A], kv[..., NOPE_A:]
    k_rope = apply_rope(k_rope, cos[None], sin[None])
    scale = (NOPE_A + ROPE_A) ** -0.5
    outs = []
    for i in range(S // QBLOCK):
        q0, kend = i * QBLOCK, (i + 1) * QBLOCK
        s = (jnp.einsum('bqhd,bkhd->bhqk', q_nope[:, q0:kend], k_nope[:, :kend])
             + jnp.einsum('bqhr,bkr->bhqk', q_rope[:, q0:kend], k_rope[:, :kend])).astype(jnp.float32) * scale
        q_pos = q0 + jnp.arange(QBLOCK)
        mask = jnp.arange(kend)[None, :] <= q_pos[:, None]
        p = jax.nn.softmax(jnp.where(mask, s, -jnp.inf), axis=-1).astype(v.dtype)
        outs.append(jnp.einsum('bhqk,bkhd->bqhd', p, v[:, :kend]))
    o = jnp.concatenate(outs, axis=1).reshape(B, S, WIDTH_A)
    return (o * jax.nn.silu(gate)) @ w_o


def moba_shared_kv(x, w_kv, cos, sin):
    B, S, _ = x.shape
    kv = x @ w_kv
    k = kv[..., :WIDTH_B].reshape(B, S, H_B, HD_B)
    v = kv[..., WIDTH_B:].reshape(B, S, H_B, HD_B)
    k = apply_rope(k, cos[None, :, None, :], sin[None, :, None, :])
    nb = -(-S // MOBA_BLOCK)
    pad = nb * MOBA_BLOCK - S
    k = jnp.pad(k, ((0, 0), (0, pad), (0, 0), (0, 0)))
    v = jnp.pad(v, ((0, 0), (0, pad), (0, 0), (0, 0)))
    k_blocks = k.reshape(B, nb, MOBA_BLOCK, H_B, HD_B).transpose(0, 3, 1, 2, 4)
    v_blocks = v.reshape(B, nb, MOBA_BLOCK, H_B, HD_B).transpose(0, 3, 1, 2, 4)
    cnt = jnp.clip(S - jnp.arange(nb) * MOBA_BLOCK, 1, MOBA_BLOCK).astype(jnp.float32)
    k_mean = (jnp.sum(k_blocks.astype(jnp.float32), axis=3) / cnt[:, None]).astype(k.dtype)
    return k_blocks, v_blocks, k_mean


def moba_mixer(x, k_blocks, v_blocks, k_mean, w_in, w_o, cos, sin):
    B, S, _ = x.shape
    nb = k_blocks.shape[2]
    h = x @ w_in
    q, gate = h[..., :WIDTH_B], h[..., WIDTH_B:]
    q = apply_rope(q.reshape(B, S, H_B, HD_B), cos[None, :, None, :], sin[None, :, None, :])
    q = q.transpose(0, 2, 1, 3)
    gs = jnp.einsum('bhsd,bhnd->bhsn', q, k_mean).astype(jnp.float32)
    q_blk = jnp.arange(S) // MOBA_BLOCK
    past = jnp.arange(nb)[None, :] < q_blk[:, None]
    gs = jnp.where(past, gs, -jnp.inf)
    topk = min(MOBA_TOPK, nb)
    _, idx = lax.top_k(gs, topk)
    valid = idx < q_blk[:, None]
    n_chunks = S // QCHUNK
    q_c = q.reshape(B, H_B, n_chunks, QCHUNK, HD_B).transpose(2, 0, 1, 3, 4)
    idx_c = idx.reshape(B, H_B, n_chunks, QCHUNK, topk).transpose(2, 0, 1, 3, 4)
    valid_c = valid.reshape(B, H_B, n_chunks, QCHUNK, topk).transpose(2, 0, 1, 3, 4)
    starts = jnp.arange(n_chunks, dtype=jnp.int32) * QCHUNK
    b_ix = jnp.arange(B)[:, None, None, None]
    h_ix = jnp.arange(H_B)[None, :, None, None]
    scale = HD_B ** -0.5

    def attend(args):
        qq, ii, vv, start = args
        k_sel = k_blocks[b_ix, h_ix, ii]
        v_sel = v_blocks[b_ix, h_ix, ii]
        qb = start // MOBA_BLOCK
        k_own = lax.dynamic_index_in_dim(k_blocks, qb, axis=2, keepdims=False)
        v_own = lax.dynamic_index_in_dim(v_blocks, qb, axis=2, keepdims=False)
        s_sel = jnp.einsum('bhcd,bhctkd->bhctk', qq, k_sel).astype(jnp.float32) * scale
        s_sel = jnp.where(vv[..., None], s_sel, -jnp.inf).reshape(B, H_B, QCHUNK, topk * MOBA_BLOCK)
        s_own = jnp.einsum('bhcd,bhkd->bhck', qq, k_own).astype(jnp.float32) * scale
        k_pos = qb * MOBA_BLOCK + jnp.arange(MOBA_BLOCK)
        q_pos = start + jnp.arange(QCHUNK)
        s_own = jnp.where(k_pos[None, :] <= q_pos[:, None], s_own, -jnp.inf)
        p = jax.nn.softmax(jnp.concatenate([s_sel, s_own], axis=-1), axis=-1).astype(qq.dtype)
        p_sel = p[..., :topk * MOBA_BLOCK].reshape(B, H_B, QCHUNK, topk, MOBA_BLOCK)
        p_own = p[..., topk * MOBA_BLOCK:]
        return (jnp.einsum('bhctk,bhctkd->bhcd', p_sel, v_sel)
                + jnp.einsum('bhck,bhkd->bhcd', p_own, v_own))

    o = lax.map(attend, (q_c, idx_c, valid_c, starts))
    o = o.transpose(1, 0, 3, 2, 4).reshape(B, S, WIDTH_B)
    return (o * jax.nn.silu(gate)) @ w_o


def setup_inputs(seed: int = 0) -> dict:
    key = jax.random.key(seed)
    ks = jax.random.split(key, 14)

    def nrm(k, shape, fan_in, scale=1.0):
        return jax.random.normal(k, shape, jnp.float32) * (scale * fan_in ** -0.5)

    x = jax.random.normal(ks[0], (BATCH, SEQ, D_MODEL), jnp.float32)
    mla_w_in = nrm(ks[1], (N_A, D_MODEL, Q_LORA + KV_LORA + ROPE_A + WIDTH_A), D_MODEL)
    mla_q_norm = 1.0 + 0.02 * jax.random.normal(ks[2], (N_A, Q_LORA), jnp.float32)
    mla_kv_norm = 1.0 + 0.02 * jax.random.normal(ks[3], (N_A, KV_LORA), jnp.float32)
    mla_w_uq = nrm(ks[4], (N_A, Q_LORA, H_A * (NOPE_A + ROPE_A)), Q_LORA)
    mla_w_ukv = nrm(ks[5], (N_A, KV_LORA, H_A * (NOPE_A + V_A)), KV_LORA)
    mla_w_o = nrm(ks[6], (N_A, WIDTH_A, D_MODEL), WIDTH_A, BETA)
    moba_w_kv = nrm(ks[7], (D_MODEL, 2 * WIDTH_B), D_MODEL)
    moba_w_in = nrm(ks[8], (N_B, D_MODEL, 2 * WIDTH_B), D_MODEL)
    moba_w_o = nrm(ks[9], (N_B, WIDTH_B, D_MODEL), WIDTH_B, BETA)
    ln_g = 1.0 + 0.02 * jax.random.normal(ks[10], (DEPTH, D_MODEL), jnp.float32)
    ln_b = 0.02 * jax.random.normal(ks[11], (DEPTH, D_MODEL), jnp.float32)
    return {"x": x, "mla_w_in": mla_w_in, "mla_q_norm": mla_q_norm, "mla_kv_norm": mla_kv_norm,
            "mla_w_uq": mla_w_uq, "mla_w_ukv": mla_w_ukv, "mla_w_o": mla_w_o,
            "moba_w_kv": moba_w_kv, "moba_w_in": moba_w_in, "moba_w_o": moba_w_o,
            "ln_g": ln_g, "ln_b": ln_b}


def reference(x, mla_w_in, mla_q_norm, mla_kv_norm, mla_w_uq, mla_w_ukv, mla_w_o,
              moba_w_kv, moba_w_in, moba_w_o, ln_g, ln_b):
    S = x.shape[1]
    cos_a, sin_a = rope_tables(S, ROPE_A)
    cos_b, sin_b = rope_tables(S, HD_B)
    shared = None
    for layer in range(DEPTH):
        if layer < N_A:
            y = mla_mixer(x, mla_w_in[layer], mla_q_norm[layer], mla_kv_norm[layer],
                          mla_w_uq[layer], mla_w_ukv[layer], mla_w_o[layer], cos_a, sin_a)
        else:
            if shared is None:
                shared = moba_shared_kv(x, moba_w_kv, cos_b, sin_b)
            j = layer - N_A
            y = moba_mixer(x, shared[0], shared[1], shared[2], moba_w_in[j], moba_w_o[j], cos_b, sin_b)
        x = layer_norm(ALPHA * x + y, ln_g[layer], ln_b[layer])
    return x
```

```cpp
#include <hip/hip_runtime.h>
#include <hip/hip_cooperative_groups.h>
#include <cstdio>
#include <cstdint>
namespace cg = cooperative_groups;
namespace pg8 {
#define PG8_LAS __attribute__((address_space(3)))
typedef unsigned short bf16_t;
typedef short bf16x8 __attribute__((ext_vector_type(8)));
typedef float f32x4 __attribute__((ext_vector_type(4)));
typedef unsigned u32x4 __attribute__((ext_vector_type(4)));
constexpr int BM = 256, BK = 64, HALF = 128, HTB = HALF * BK * 2  , STAGE_BYTES = 8 * HTB, NXCD = 8, WGM = 8;

__host__ __device__ __forceinline__ int lds_byte(int r, int c) { const int st = (r >> 4) * 2 + (c >> 5), rr = r & 15, cc = c & 31, ob = rr * 64 + cc * 2; return st * 1024 + (ob ^ (((ob >> 9) & 1) << 5)); }
__host__ __device__ __forceinline__ void stage_rc(int b, int& R, int& C) { const int st = b / 1024, sb = b % 1024, swz = sb ^ (((sb >> 9) & 1) << 5); R = (st >> 1) * 16 + swz / 64; C = (st & 1) * 32 + (swz % 64) / 2; }
__host__ __device__ __forceinline__ int perm32(int rho) { const int n = rho >> 4, i = rho & 15; return 8 * (i >> 2) + 4 * n + (i & 3); }

struct Unit { int pm, pn; };
struct Gemm { const bf16_t* A; const bf16_t* Bt; int M, N, K; };

struct StaticOrder {
    int nM, nN, nwg, G, c;
    __host__ __device__ void init(int M, int N, int G_, int c_) { nM = M / BM; nN = N / BM; nwg = nM * nN; G = G_; c = c_; }
    __host__ __device__ bool next(int i, Unit& u) const {
        const long L = (long)i * G + c; if (L >= nwg) return false;
        int wgid = (int)L; { const int q = nwg / NXCD, r = nwg % NXCD, xcd = wgid % NXCD, off = wgid / NXCD; wgid = (xcd < r ? xcd * (q + 1) : r * (q + 1) + (xcd - r) * q) + off; }
        const int nig = WGM * nN, gid = wgid / nig, fm = gid * WGM, gsz = (nM - fm) < WGM ? (nM - fm) : WGM;
        u.pm = fm + ((wgid % nig) % gsz); u.pn = (wgid % nig) / gsz; return true;
    }
    __device__ __forceinline__ void a_ready(const Unit&) const {}
    __device__ __forceinline__ void done(const Unit&) const {}
};

__device__ __forceinline__ unsigned cvt_pk_bf16(float lo, float hi) { unsigned r; asm volatile("v_cvt_pk_bf16_f32 %0, %1, %2" : "=v"(r) : "v"(lo), "v"(hi)); return r; }
typedef unsigned u32x2 __attribute__((ext_vector_type(2)));
__device__ __forceinline__ void st_bf16x4(bf16_t* p, f32x4 v) { u32x2 w; w.x = cvt_pk_bf16(v[0], v[1]); w.y = cvt_pk_bf16(v[2], v[3]); *(u32x2*)p = w; }
__device__ __forceinline__ float silu_f(float v) { return v * __builtin_amdgcn_rcpf(1.0f + __builtin_amdgcn_exp2f(-1.4426950408889634f * v)); }
__device__ __forceinline__ f32x4 silu4(f32x4 v) { return (f32x4){silu_f(v[0]), silu_f(v[1]), silu_f(v[2]), silu_f(v[3])}; }


struct Epi1 {
    static constexpr bool PERM = false, AFTER_DRAIN = false;
    bf16_t* cq; bf16_t* ckv; bf16_t* gate; bf16_t* krope; float* ssq; const float* cosA; const float* sinA;
    __device__ __forceinline__ void operator()(const f32x4 (&acc)[2][2][4][2], const Unit& u, int wr, int wc, int fr, int fq) const {
        const int pn = u.pn;
#pragma unroll
        for (int ai = 0; ai < 2; ++ai)
#pragma unroll
            for (int m = 0; m < 4; ++m) {
                const int row = u.pm * BM + ai * HALF + wr * 64 + m * 16 + fr;
                if (pn < 4) {
                    float s = 0.f;
                    bf16_t* dst = (pn < 3) ? cq + (size_t)row * 768 + pn * 256 : ckv + (size_t)row * 256;
#pragma unroll
                    for (int bj = 0; bj < 2; ++bj)
#pragma unroll
                        for (int n = 0; n < 2; ++n) { const f32x4 v = acc[ai][bj][m][n]; s += (v[0] * v[0] + v[1] * v[1]) + (v[2] * v[2] + v[3] * v[3]);
                            st_bf16x4(dst + bj * HALF + wc * 32 + n * 16 + 4 * fq, v); }
                    s += __shfl_xor(s, 16); s += __shfl_xor(s, 32);
                    if (fq == 0) ssq[(size_t)row * 16 + pn * 4 + wc] = s;
                } else if (pn < 8) {
                    bf16_t* dst = gate + (size_t)row * 1024 + (pn - 4) * 256;
#pragma unroll
                    for (int bj = 0; bj < 2; ++bj)
#pragma unroll
                        for (int n = 0; n < 2; ++n) st_bf16x4(dst + bj * HALF + wc * 32 + n * 16 + 4 * fq, silu4(acc[ai][bj][m][n]));
                } else if (wc == 0) {
                    const int pos = row & 2047;
                    const f32x4 c = *(const f32x4*)(cosA + pos * 16 + 4 * fq), sn = *(const f32x4*)(sinA + pos * 16 + 4 * fq);
                    const f32x4 v0 = acc[ai][0][m][0], v1 = acc[ai][0][m][1];
                    st_bf16x4(krope + (size_t)row * 32 + 4 * fq, v0 * c - v1 * sn);
                    st_bf16x4(krope + (size_t)row * 32 + 16 + 4 * fq, v1 * c + v0 * sn);
                }
            }
    }
};
struct Epi2 {
    static constexpr bool PERM = false, AFTER_DRAIN = false;
    bf16_t* Q; const float* ssq; const float* cosA; const float* sinA; float qs;
    __device__ __forceinline__ void operator()(const f32x4 (&acc)[2][2][4][2], const Unit& u, int wr, int wc, int fr, int fq) const {
#pragma unroll
        for (int ai = 0; ai < 2; ++ai)
#pragma unroll
            for (int m = 0; m < 4; ++m) {
                const int row = u.pm * BM + ai * HALF + wr * 64 + m * 16 + fr;
                const f32x4* sp = (const f32x4*)(ssq + (size_t)row * 16);
                const f32x4 s0 = sp[0], s1 = sp[1], s2 = sp[2];
                const float t = ((s0[0] + s0[1]) + (s0[2] + s0[3])) + ((s1[0] + s1[1]) + (s1[2] + s1[3])) + ((s2[0] + s2[1]) + (s2[2] + s2[3]));
                const float sc = qs / sqrtf(t * (1.0f / 768.0f) + 1e-6f);
                const int pos = row & 2047;
                bf16_t* dst = Q + (size_t)row * 1536 + u.pn * 256 + wc * 32 + 4 * fq;
#pragma unroll
                for (int bj = 0; bj < 2; ++bj) {
                    const int g = u.pn * 8 + bj * 4 + wc;
                    const f32x4 v0 = acc[ai][bj][m][0] * sc, v1 = acc[ai][bj][m][1] * sc;
                    if (g % 3 == 2) {
                        const f32x4 c = *(const f32x4*)(cosA + pos * 16 + 4 * fq), sn = *(const f32x4*)(sinA + pos * 16 + 4 * fq);
                        st_bf16x4(dst + bj * HALF, v0 * c - v1 * sn); st_bf16x4(dst + bj * HALF + 16, v1 * c + v0 * sn);
                    } else { st_bf16x4(dst + bj * HALF, v0); st_bf16x4(dst + bj * HALF + 16, v1); }
                }
            }
    }
};
struct Epi3 {
    static constexpr bool PERM = false, AFTER_DRAIN = false;
    bf16_t* K; bf16_t* V; const float* ssq;
    __device__ __forceinline__ void operator()(const f32x4 (&acc)[2][2][4][2], const Unit& u, int wr, int wc, int fr, int fq) const {
#pragma unroll
        for (int ai = 0; ai < 2; ++ai)
#pragma unroll
            for (int m = 0; m < 4; ++m) {
                const int row = u.pm * BM + ai * HALF + wr * 64 + m * 16 + fr;
                const f32x4 s3 = *(const f32x4*)(ssq + (size_t)row * 16 + 12);
                const float sc = 1.0f / sqrtf(((s3[0] + s3[1]) + (s3[2] + s3[3])) * (1.0f / 256.0f) + 1e-6f);
                bf16_t* dst = ((u.pn < 4) ? K : V) + (size_t)row * 1024 + (u.pn & 3) * 256 + wc * 32 + 4 * fq;
#pragma unroll
                for (int bj = 0; bj < 2; ++bj)
#pragma unroll
                    for (int n = 0; n < 2; ++n) st_bf16x4(dst + bj * HALF + n * 16, acc[ai][bj][m][n] * sc);
            }
    }
};
struct Epi4 {
    static constexpr bool PERM = false, AFTER_DRAIN = false;
    const float* res; float* out; float alpha;
    __device__ __forceinline__ void operator()(const f32x4 (&acc)[2][2][4][2], const Unit& u, int wr, int wc, int fr, int fq) const {
#pragma unroll
        for (int ai = 0; ai < 2; ++ai)
#pragma unroll
            for (int m = 0; m < 4; ++m) {
                const size_t off = (size_t)(u.pm * BM + ai * HALF + wr * 64 + m * 16 + fr) * 1024 + u.pn * 256 + wc * 32 + 4 * fq;
#pragma unroll
                for (int bj = 0; bj < 2; ++bj)
#pragma unroll
                    for (int n = 0; n < 2; ++n) { const f32x4 r = *(const f32x4*)(res + off + bj * HALF + n * 16); *(f32x4*)(out + off + bj * HALF + n * 16) = r * alpha + acc[ai][bj][m][n]; }
            }
    }
};
struct Epi5 {
    static constexpr bool PERM = false, AFTER_DRAIN = false;
    bf16_t* K; bf16_t* V; bf16_t* Q; bf16_t* gate; const float* cosB; const float* sinB; float qs;
    __device__ __forceinline__ void operator()(const f32x4 (&acc)[2][2][4][2], const Unit& u, int wr, int wc, int fr, int fq) const {
        const int sect = u.pn >> 2, pq = u.pn & 3;
#pragma unroll
        for (int ai = 0; ai < 2; ++ai)
#pragma unroll
            for (int m = 0; m < 4; ++m) {
                const int row = u.pm * BM + ai * HALF + wr * 64 + m * 16 + fr;
                if (sect == 0 || sect == 2) {
                    const int pos = row & 2047, d1 = 16 * (wc & 1) + 4 * fq;
                    const f32x4 c = *(const f32x4*)(cosB + pos * 32 + d1), sn = *(const f32x4*)(sinB + pos * 32 + d1);
                    const float sc = (sect == 2) ? qs : 1.0f;
                    bf16_t* dst = ((sect == 0) ? K : Q) + (size_t)row * 1024 + pq * 256 + (wc >> 1) * 64 + d1;
#pragma unroll
                    for (int bj = 0; bj < 2; ++bj) { const f32x4 v0 = acc[ai][bj][m][0] * sc, v1 = acc[ai][bj][m][1] * sc;
                        st_bf16x4(dst + bj * HALF, v0 * c - v1 * sn); st_bf16x4(dst + bj * HALF + 32, v1 * c + v0 * sn); }
                } else {
                    bf16_t* dst = ((sect == 1) ? V : gate) + (size_t)row * 1024 + pq * 256 + wc * 32 + 4 * fq;
#pragma unroll
                    for (int bj = 0; bj < 2; ++bj)
#pragma unroll
                        for (int n = 0; n < 2; ++n) st_bf16x4(dst + bj * HALF + n * 16, (sect == 1) ? acc[ai][bj][m][n] : silu4(acc[ai][bj][m][n]));
                }
            }
    }
};

template <class Epi, class Sched, bool ALIGN_EPI = false, bool SP2 = false>
__device__ __forceinline__ void gemm_phase(PG8_LAS unsigned char* lds, const Gemm g, const Sched& S, const Epi& E) {
    const int tid = threadIdx.x, wid = __builtin_amdgcn_readfirstlane(tid >> 6), lane = tid & 63, wr = wid >> 2, wc = wid & 3, fr = lane & 15, fq = lane >> 4;
    const int K = g.K, nt = K / BK;
    unsigned voffA[2], voffB[2];
#pragma unroll
    for (int i = 0; i < 2; ++i) { int R, C; stage_rc(tid * 16 + i * 8192, R, C); const int Rb = Epi::PERM ? ((R & ~31) + perm32(R & 31)) : R;
        voffA[i] = (unsigned)(R * K + C) * 2u; voffB[i] = (unsigned)(Rb * K + C) * 2u; }
    const size_t kstep = (size_t)(BK * 2);
    const size_t hstep = (size_t)HALF * K * 2;
    const size_t tstep = 2 * hstep;
    const unsigned ldsw = (unsigned)wid * 1024u;
    const int aoff = lds_byte(wr * 64 + fr, fq * 8), boff = lds_byte(wc * 32 + fr, fq * 8);
#define PG8_SA(b, h) (((b) * 2 + (h)) * HTB)
#define PG8_SB(b, h) ((4 + (b) * 2 + (h)) * HTB)
#define PG8_STAGE(bufoff, gbase, voff) do { _Pragma("unroll") for (int _i = 0; _i < 2; ++_i) \
        __builtin_amdgcn_global_load_lds((const unsigned*)((const char*)(gbase) + (voff)[_i]), (PG8_LAS unsigned*)(lds + (bufoff) + ldsw + _i * 8192), 16, 0, 0); } while (0)
#define PG8_LDA(dst, b, h) do { _Pragma("unroll") for (int m = 0; m < 4; ++m) _Pragma("unroll") for (int k = 0; k < 2; ++k) dst[m][k] = *(const PG8_LAS bf16x8*)(lds + PG8_SA(b, h) + aoff + m * 2048 + k * 1024); } while (0)
#define PG8_LDB(dst, b, h) do { _Pragma("unroll") for (int n = 0; n < 2; ++n) _Pragma("unroll") for (int k = 0; k < 2; ++k) dst[n][k] = *(const PG8_LAS bf16x8*)(lds + PG8_SB(b, h) + boff + n * 2048 + k * 1024); } while (0)
#define PG8_MMA(ai, bj, At, Bt) do { __builtin_amdgcn_s_setprio(1); _Pragma("unroll") for (int m = 0; m < 4; ++m) _Pragma("unroll") for (int n = 0; n < 2; ++n) _Pragma("unroll") for (int k = 0; k < 2; ++k) \
        acc[ai][bj][m][n] = __builtin_amdgcn_mfma_f32_16x16x32_bf16(Bt[n][k], At[m][k], acc[ai][bj][m][n], 0, 0, 0); __builtin_amdgcn_s_setprio(0); } while (0)
#define PG8_WAIT_V(n) asm volatile("s_waitcnt vmcnt(" #n ")" ::: "memory")
#define PG8_WAIT_L(n) asm volatile("s_waitcnt lgkmcnt(" #n ")" ::: "memory")
#define PG8_BAR __builtin_amdgcn_s_barrier()
#define PG8_SCHED __builtin_amdgcn_sched_barrier(0)
    Unit cur, nxt; int ui = 0;
    if (!S.next(0, cur)) return;
    f32x4 acc[2][2][4][2];
#pragma unroll
    for (int a = 0; a < 2; ++a)
#pragma unroll
        for (int b = 0; b < 2; ++b)
#pragma unroll
            for (int m = 0; m < 4; ++m)
#pragma unroll
                for (int n = 0; n < 2; ++n) acc[a][b][m][n] = (f32x4){0.f, 0.f, 0.f, 0.f};
    bf16x8 At[4][2], B0[2][2], B1[2][2];
    const char* cA = (const char*)g.A + (size_t)cur.pm * tstep; const char* cB = (const char*)g.Bt + (size_t)cur.pn * tstep;
    S.a_ready(cur);
    if constexpr (SP2) {
        PG8_STAGE(PG8_SB(0, 0), cB, voffB); PG8_STAGE(PG8_SB(0, 1), cB + hstep, voffB); PG8_STAGE(PG8_SA(0, 0), cA, voffA); PG8_STAGE(PG8_SA(0, 1), cA + hstep, voffA);
        if (wr == 1) PG8_BAR;
        PG8_WAIT_V(2); PG8_BAR;
        PG8_STAGE(PG8_SB(1, 0), cB + kstep, voffB); PG8_STAGE(PG8_SA(1, 0), cA + kstep, voffA); PG8_STAGE(PG8_SB(1, 1), cB + hstep + kstep, voffB);
        PG8_WAIT_V(6); PG8_BAR;
    } else {
        PG8_STAGE(PG8_SB(0, 0), cB, voffB); PG8_STAGE(PG8_SA(0, 0), cA, voffA); PG8_STAGE(PG8_SB(0, 1), cB + hstep, voffB); PG8_STAGE(PG8_SA(0, 1), cA + hstep, voffA);
        if (wr == 1) PG8_BAR;
        PG8_WAIT_V(4); PG8_BAR;
        PG8_STAGE(PG8_SB(1, 0), cB + kstep, voffB); PG8_STAGE(PG8_SA(1, 0), cA + kstep, voffA); PG8_STAGE(PG8_SB(1, 1), cB + hstep + kstep, voffB);
        PG8_WAIT_V(6); PG8_BAR;
    }
    for (;;) {
        const bool has_next = S.next(ui + 1, nxt);
        const char* nA = has_next ? (const char*)g.A + (size_t)nxt.pm * tstep : cA; const char* nB = has_next ? (const char*)g.Bt + (size_t)nxt.pn * tstep : cB;
        for (int t = 0; t < nt; t += 2) {
            const bool last = (t == nt - 2);
            const char* a1 = cA + (size_t)(t + 1) * kstep;
            const char* a2 = last ? nA : cA + (size_t)(t + 2) * kstep; const char* b2 = last ? nB : cB + (size_t)(t + 2) * kstep;
            const char* a3 = a2 + kstep; const char* b3 = b2 + kstep;
            if (last && has_next) S.a_ready(nxt);
            if constexpr (SP2) {
            PG8_LDB(B0, 0, 0); PG8_LDB(B1, 0, 1); PG8_SCHED; PG8_LDA(At, 0, 0); PG8_STAGE(PG8_SA(1, 1), a1 + hstep, voffA);
            PG8_WAIT_V(8); PG8_WAIT_L(0); PG8_BAR; PG8_MMA(0, 0, At, B0); PG8_MMA(0, 1, At, B1); PG8_BAR; PG8_SCHED;
            PG8_LDA(At, 0, 1); PG8_STAGE(PG8_SB(0, 0), b2, voffB); PG8_STAGE(PG8_SB(0, 1), b2 + hstep, voffB); PG8_STAGE(PG8_SA(0, 0), a2, voffA);
            PG8_WAIT_V(8); PG8_WAIT_L(0); PG8_BAR; PG8_MMA(1, 0, At, B0); PG8_MMA(1, 1, At, B1); PG8_BAR; PG8_SCHED;
            PG8_LDB(B0, 1, 0); PG8_LDB(B1, 1, 1); PG8_SCHED; PG8_LDA(At, 1, 0); PG8_STAGE(PG8_SA(0, 1), a2 + hstep, voffA);
            PG8_WAIT_V(8); PG8_WAIT_L(0); PG8_BAR; PG8_MMA(0, 0, At, B0); PG8_MMA(0, 1, At, B1); PG8_BAR; PG8_SCHED;
            PG8_LDA(At, 1, 1); PG8_STAGE(PG8_SB(1, 0), b3, voffB); PG8_STAGE(PG8_SB(1, 1), b3 + hstep, voffB); PG8_STAGE(PG8_SA(1, 0), a3, voffA);
            PG8_WAIT_V(8); PG8_WAIT_L(0); PG8_BAR; PG8_MMA(1, 0, At, B0); PG8_MMA(1, 1, At, B1); PG8_BAR; PG8_SCHED;
            } else {
            PG8_LDB(B0, 0, 0); PG8_SCHED; PG8_LDA(At, 0, 0); PG8_STAGE(PG8_SA(1, 1), a1 + hstep, voffA);
            PG8_WAIT_L(8); PG8_BAR; PG8_WAIT_L(0); PG8_MMA(0, 0, At, B0); PG8_BAR; PG8_SCHED;
            PG8_LDB(B1, 0, 1); PG8_STAGE(PG8_SB(0, 0), b2, voffB);
            PG8_BAR; PG8_WAIT_L(0); PG8_MMA(0, 1, At, B1); PG8_BAR;
            PG8_LDA(At, 0, 1); PG8_STAGE(PG8_SA(0, 0), a2, voffA);
            PG8_BAR; PG8_WAIT_L(0); PG8_MMA(1, 0, At, B0); PG8_BAR; PG8_SCHED;
            PG8_STAGE(PG8_SB(0, 1), b2 + hstep, voffB);
            PG8_WAIT_V(6); PG8_BAR; PG8_MMA(1, 1, At, B1); PG8_BAR;
            PG8_LDB(B0, 1, 0); PG8_SCHED; PG8_LDA(At, 1, 0); PG8_STAGE(PG8_SA(0, 1), a2 + hstep, voffA);
            PG8_WAIT_L(8); PG8_BAR; PG8_WAIT_L(0); PG8_MMA(0, 0, At, B0); PG8_BAR; PG8_SCHED;
            PG8_LDB(B1, 1, 1); PG8_STAGE(PG8_SB(1, 0), b3, voffB);
            PG8_BAR; PG8_WAIT_L(0); PG8_MMA(0, 1, At, B1); PG8_BAR;
            PG8_LDA(At, 1, 1); PG8_STAGE(PG8_SA(1, 0), a3, voffA);
            PG8_BAR; PG8_WAIT_L(0); PG8_MMA(1, 0, At, B0); PG8_BAR; PG8_SCHED;
            PG8_STAGE(PG8_SB(1, 1), b3 + hstep, voffB);
            PG8_WAIT_V(6); PG8_BAR; PG8_MMA(1, 1, At, B1); PG8_BAR;
            }
        }
        if constexpr (ALIGN_EPI) { if (wr == 0) PG8_BAR; }
        if constexpr (!Epi::AFTER_DRAIN) { E(acc, cur, wr, wc, fr, fq); S.done(cur); }
        if (!has_next) break;
#pragma unroll
        for (int a = 0; a < 2; ++a)
#pragma unroll
            for (int b = 0; b < 2; ++b)
#pragma unroll
                for (int m = 0; m < 4; ++m)
#pragma unroll
                    for (int n = 0; n < 2; ++n) acc[a][b][m][n] = (f32x4){0.f, 0.f, 0.f, 0.f};
        cur = nxt; cA = nA; cB = nB; ++ui;
        if constexpr (ALIGN_EPI) { if (wr == 1) PG8_BAR; }
    }
    PG8_WAIT_V(0);
    if constexpr (!ALIGN_EPI) { if (wr == 0) PG8_BAR; }
    PG8_BAR;
    if constexpr (Epi::AFTER_DRAIN) { E.fused(acc, cur, wr, wc, fr, fq, lds, wid, lane); S.done(cur); }
#undef PG8_SA
#undef PG8_SB
#undef PG8_STAGE
#undef PG8_LDA
#undef PG8_LDB
#undef PG8_MMA
#undef PG8_WAIT_V
#undef PG8_WAIT_L
#undef PG8_BAR
#undef PG8_SCHED
}
}

#define LAS __attribute__((address_space(3)))
typedef unsigned short bf16;
typedef short bf16x8 __attribute__((ext_vector_type(8)));
typedef short s16x4 __attribute__((ext_vector_type(4)));
typedef float f32x4 __attribute__((ext_vector_type(4)));
typedef float f32x16 __attribute__((ext_vector_type(16)));
typedef unsigned u32x4 __attribute__((ext_vector_type(4)));
typedef unsigned u32x2 __attribute__((ext_vector_type(2)));

constexpr int NB = 16, SEQ = 2048, DMODEL = 1024, MT = NB * SEQ, NHEAD = 16;
constexpr float ALPHA = 1.4142135623730951f;
constexpr float LOG2E = 1.4426950408889634f;
constexpr float QS_A = 0.10206207261596575f * LOG2E;
constexpr float QS_B = 0.125f * LOG2E;
constexpr size_t MiB = 1u << 20;
constexpr size_t WS_W1T = 0, WS_WUQT = 5 * MiB, WS_WUKVT = 8 * MiB, WS_WOT = 9 * MiB, WS_W5T = 11 * MiB, WS_WO2T = 19 * MiB;
constexpr size_t WS_TAB = 21 * MiB, WS_KMEAN = 22 * MiB, WS_SSQ = 23 * MiB, WS_KROPE = 25 * MiB;
constexpr size_t WS_XB = 32 * MiB, WS_CQ = 96 * MiB, WS_CKV = 144 * MiB, WS_GATE = 160 * MiB, WS_Q = 224 * MiB, WS_K = 320 * MiB, WS_V = 384 * MiB, WS_END = 448 * MiB;
constexpr int LDS_BYTES = 131072 + 1024;
constexpr int NWAVES = 8;

__device__ __forceinline__ float bf2f(short s) { return __uint_as_float(((unsigned)(unsigned short)s) << 16); }
__device__ __forceinline__ unsigned f2bf(float f) { unsigned u = __builtin_bit_cast(unsigned, f); return (u + 0x7fffu + ((u >> 16) & 1u)) >> 16; }
__device__ __forceinline__ unsigned pk2(float lo, float hi) { return f2bf(lo) | (f2bf(hi) << 16); }
__device__ __forceinline__ unsigned cvtpk(float lo, float hi) { unsigned r; asm volatile("v_cvt_pk_bf16_f32 %0, %1, %2" : "=v"(r) : "v"(lo), "v"(hi)); return r; }
__device__ __forceinline__ float wave_sum(float v) {
#pragma unroll
    for (int o = 1; o < 64; o <<= 1) v += __shfl_xor(v, o);
    return v;
}

__device__ __forceinline__ int crow(int r, int hi) { return (r & 3) + 8 * (r >> 2) + 4 * hi; }
typedef short v4i16_t __attribute__((ext_vector_type(4)));
__device__ __forceinline__ s16x4 vtr(const LAS unsigned char* p) { return __builtin_bit_cast(s16x4, __builtin_amdgcn_ds_read_tr16_b64_v4i16((LAS v4i16_t*)p)); }

template <int DQK, bool MOBA>
__device__ __forceinline__ void attn_unit(LAS unsigned char* lds, int b, int h, int qb,
                                          const bf16* __restrict__ Q, int ldq, const bf16* __restrict__ K, const bf16* __restrict__ KR,
                                          const bf16* __restrict__ V, bf16* G, const float* __restrict__ kmean) {
    constexpr int NKS = DQK / 16, NCH = DQK / 8, KBUF = NCH * 1024, OFF_V = 2 * KBUF, VBUF = 8192;
    const int tid = threadIdx.x, lane = tid & 63, r32 = lane & 31, hi = lane >> 5;
    const int wid = __builtin_amdgcn_readfirstlane(tid >> 6);
    const size_t rowbase = (size_t)b * SEQ;
    const int q0 = qb * 256;
    bf16x8 qr[NKS];
    {
        const bf16* qp = Q + (rowbase + q0 + wid * 32 + r32) * (size_t)ldq + h * DQK + hi * 8;
#pragma unroll
        for (int ks = 0; ks < NKS; ++ks) qr[ks] = *(const bf16x8*)(qp + ks * 16);
    }
    unsigned sel = 0u;
    if (MOBA) {
        float gs[7];
#pragma unroll
        for (int j = 0; j < 7; ++j) {
            float a = -INFINITY;
            if (j < qb) {
                const float* km = kmean + ((size_t)(b * NHEAD + h) * 8 + j) * 64 + hi * 8;
                float s = 0.f;
#pragma unroll
                for (int ks = 0; ks < NKS; ++ks) {
                    const f32x4 k0 = *(const f32x4*)(km + ks * 16), k1 = *(const f32x4*)(km + ks * 16 + 4);
                    s += bf2f(qr[ks][0]) * k0[0] + bf2f(qr[ks][1]) * k0[1] + bf2f(qr[ks][2]) * k0[2] + bf2f(qr[ks][3]) * k0[3];
                    s += bf2f(qr[ks][4]) * k1[0] + bf2f(qr[ks][5]) * k1[1] + bf2f(qr[ks][6]) * k1[2] + bf2f(qr[ks][7]) * k1[3];
                }
                a = s + __shfl_xor(s, 32);
            }
            gs[j] = a;
        }
#pragma unroll
        for (int k = 0; k < 3; ++k) {
            float best = -INFINITY; int bi = -1;
#pragma unroll
            for (int j = 0; j < 7; ++j) { const bool c = (((sel >> j) & 1u) == 0u) && (gs[j] > best); best = c ? gs[j] : best; bi = c ? j : bi; }
            if (bi >= 0) sel |= 1u << bi;
        }
    }
    const int skey = tid >> 3, sch = tid & 7;
    const bf16* kg = K + (rowbase + skey) * 1024 + h * 64 + sch * 8;
    const bf16* vg = V + (rowbase + skey) * 1024 + h * 64 + sch * 8;
    const unsigned kdst = sch * 1024 + ((skey ^ sch) * 16);
    const unsigned vdst = OFF_V + ((sch >> 2) * 4 + (skey >> 4)) * 1024 + (skey & 15) * 64 + (sch & 3) * 16;
    const int rkey = (tid >> 2) & 63, rch = tid & 3;
    const bf16* rg = (DQK == 96) ? KR + (rowbase + rkey) * 32 + rch * 8 : nullptr;
    const unsigned rdst = (8 + rch) * 1024 + ((rkey ^ rch) * 16);
    const bool rope_loader = (DQK == 96) && (tid < 256);
    const unsigned kread = r32 * 16;
    const unsigned vread = OFF_V + ((lane >> 4) & 1) * 32 + (lane & 3) * 8 + (4 * hi + ((lane & 15) >> 2)) * 64;

    const int NT = 4 * qb + 4;
#define TILE_OF(i) (MOBA ? (((i) < 4) ? 4 * qb + (i) : (i) - 4) : (i))

    u32x4 kst, vst, rst;
    {
        const int t0 = TILE_OF(0);
        kst = *(const u32x4*)(kg + (size_t)t0 * 64 * 1024); vst = *(const u32x4*)(vg + (size_t)t0 * 64 * 1024);
        if (rope_loader) rst = *(const u32x4*)(rg + (size_t)t0 * 64 * 32);
        *(LAS u32x4*)(lds + kdst) = kst; *(LAS u32x4*)(lds + vdst) = vst;
        if (rope_loader) *(LAS u32x4*)(lds + rdst) = rst;
    }
    __syncthreads();
    float mrow = -INFINITY, lrow = 0.f;
    f32x16 o0 = {}, o1 = {};
    for (int i = 0; i < NT; ++i) {
        const int t = TILE_OF(i);
        const int st = i & 1;
        if (i + 1 < NT) {
            const int tn = TILE_OF(i + 1);
            kst = *(const u32x4*)(kg + (size_t)tn * 64 * 1024); vst = *(const u32x4*)(vg + (size_t)tn * 64 * 1024);
            if (rope_loader) rst = *(const u32x4*)(rg + (size_t)tn * 64 * 32);
        }
        const int bt = t - 4 * qb;
        const bool needed = (bt < 0) || (64 * bt <= 32 * wid + 31);
        if (needed) {
            const LAS unsigned char* kb = lds + st * KBUF;
            f32x16 p0 = {}, p1 = {};
#pragma unroll
            for (int ks = 0; ks < NKS; ++ks) {
                const int c = 2 * ks + hi;
                const LAS unsigned char* ka = kb + c * 1024 + ((r32 ^ (c & 7)) * 16);
                const bf16x8 a0 = *(const LAS bf16x8*)(ka), a1 = *(const LAS bf16x8*)(ka + 512);
                p0 = __builtin_amdgcn_mfma_f32_32x32x16_bf16(a0, qr[ks], p0, 0, 0, 0);
                p1 = __builtin_amdgcn_mfma_f32_32x32x16_bf16(a1, qr[ks], p1, 0, 0, 0);
            }
            if (bt >= 0) {
                if (64 * bt + 63 > 32 * wid) {
                    const int qrel = 32 * wid + r32;
#pragma unroll
                    for (int r = 0; r < 16; ++r) { const int kv = 64 * bt + crow(r, hi); if (kv > qrel) p0[r] = -INFINITY; if (kv + 32 > qrel) p1[r] = -INFINITY; }
                }
            } else if (MOBA) {
                if (((sel >> (t >> 2)) & 1u) == 0u) {
#pragma unroll
                    for (int r = 0; r < 16; ++r) { p0[r] = -INFINITY; p1[r] = -INFINITY; }
                }
            }
            float rm = fmaxf(p0[0], p1[0]);
#pragma unroll
            for (int r = 1; r < 16; ++r) rm = fmaxf(rm, fmaxf(p0[r], p1[r]));
            rm = fmaxf(rm, __shfl_xor(rm, 32));
            const float mn = fmaxf(mrow, rm);
            const float mu = (mn == -INFINITY) ? 0.f : mn;
            const float f = __builtin_amdgcn_exp2f(mrow - mu);
            mrow = mn;
            lrow *= f;
#pragma unroll
            for (int r = 0; r < 16; ++r) { o0[r] *= f; o1[r] *= f; }
            float ls = 0.f;
#pragma unroll
            for (int r = 0; r < 16; ++r) { p0[r] = __builtin_amdgcn_exp2f(p0[r] - mu); p1[r] = __builtin_amdgcn_exp2f(p1[r] - mu); ls += p0[r] + p1[r]; }
            lrow += ls;
            bf16x8 pw[4];
            { u32x4 w;
              w.x = cvtpk(p0[0], p0[1]); w.y = cvtpk(p0[2], p0[3]); w.z = cvtpk(p0[4], p0[5]); w.w = cvtpk(p0[6], p0[7]); pw[0] = __builtin_bit_cast(bf16x8, w);
              w.x = cvtpk(p0[8], p0[9]); w.y = cvtpk(p0[10], p0[11]); w.z = cvtpk(p0[12], p0[13]); w.w = cvtpk(p0[14], p0[15]); pw[1] = __builtin_bit_cast(bf16x8, w);
              w.x = cvtpk(p1[0], p1[1]); w.y = cvtpk(p1[2], p1[3]); w.z = cvtpk(p1[4], p1[5]); w.w = cvtpk(p1[6], p1[7]); pw[2] = __builtin_bit_cast(bf16x8, w);
              w.x = cvtpk(p1[8], p1[9]); w.y = cvtpk(p1[10], p1[11]); w.z = cvtpk(p1[12], p1[13]); w.w = cvtpk(p1[14], p1[15]); pw[3] = __builtin_bit_cast(bf16x8, w); }
            const LAS unsigned char* vb = lds + vread + st * VBUF;
#pragma unroll
            for (int ks = 0; ks < 4; ++ks) {
                const s16x4 a_lo = vtr(vb + ks * 1024), a_hi = vtr(vb + ks * 1024 + 512);
                const s16x4 b_lo = vtr(vb + 4096 + ks * 1024), b_hi = vtr(vb + 4096 + ks * 1024 + 512);
                const bf16x8 va = (bf16x8){a_lo[0], a_lo[1], a_lo[2], a_lo[3], a_hi[0], a_hi[1], a_hi[2], a_hi[3]};
                const bf16x8 vb8 = (bf16x8){b_lo[0], b_lo[1], b_lo[2], b_lo[3], b_hi[0], b_hi[1], b_hi[2], b_hi[3]};
                o0 = __builtin_amdgcn_mfma_f32_32x32x16_bf16(va, pw[ks], o0, 0, 0, 0);
                o1 = __builtin_amdgcn_mfma_f32_32x32x16_bf16(vb8, pw[ks], o1, 0, 0, 0);
            }
        }
        if (i + 1 < NT) {
            const unsigned so = (st ^ 1);
            *(LAS u32x4*)(lds + so * KBUF + kdst) = kst; *(LAS u32x4*)(lds + so * VBUF + vdst) = vst;
            if (rope_loader) *(LAS u32x4*)(lds + so * KBUF + rdst) = rst;
        }
        __syncthreads();
    }
    lrow += __shfl_xor(lrow, 32);
    const float inv = 1.0f / lrow;
    bf16* gp = G + (rowbase + q0 + wid * 32 + r32) * 1024 + h * 64 + 4 * hi;
#pragma unroll
    for (int g = 0; g < 4; ++g) {
        const u32x2 g0 = *(const u32x2*)(gp + 8 * g), g1 = *(const u32x2*)(gp + 32 + 8 * g);
        u32x2 w0, w1;
        w0.x = cvtpk(o0[4 * g] * inv * __uint_as_float(g0.x << 16), o0[4 * g + 1] * inv * __uint_as_float(g0.x & 0xffff0000u));
        w0.y = cvtpk(o0[4 * g + 2] * inv * __uint_as_float(g0.y << 16), o0[4 * g + 3] * inv * __uint_as_float(g0.y & 0xffff0000u));
        w1.x = cvtpk(o1[4 * g] * inv * __uint_as_float(g1.x << 16), o1[4 * g + 1] * inv * __uint_as_float(g1.x & 0xffff0000u));
        w1.y = cvtpk(o1[4 * g + 2] * inv * __uint_as_float(g1.y << 16), o1[4 * g + 3] * inv * __uint_as_float(g1.y & 0xffff0000u));
        *(u32x2*)(gp + 8 * g) = w0; *(u32x2*)(gp + 32 + 8 * g) = w1;
    }
}
#undef TILE_OF

__device__ __forceinline__ int swap45(int d) { return (d & 15) | ((d & 16) << 1) | ((d & 32) >> 1); }
__device__ __forceinline__ void transpose_item(const float* __restrict__ W, int K, int Nsrc, bf16* WT, LAS float* scr, int k0, int n0, int srccol, const float* __restrict__ kscale, int lane) {
#pragma unroll 8
    for (int i = 0; i < 32; ++i) { const int kk = 2 * i + (lane >> 5);
        float v = (srccol >= 0) ? W[(size_t)(k0 + kk) * Nsrc + srccol] : 0.f;
        if (kscale) v *= kscale[k0 + kk];
        scr[kk * 33 + (lane & 31)] = v; }
    asm volatile("s_waitcnt lgkmcnt(0)" ::: "memory");
    const int c = lane & 7;
#pragma unroll
    for (int j = 0; j < 4; ++j) { const int n = (lane >> 3) + 8 * j; const LAS float* s = scr + (8 * c) * 33 + n;
        u32x4 o; o.x = pk2(s[0 * 33], s[1 * 33]); o.y = pk2(s[2 * 33], s[3 * 33]); o.z = pk2(s[4 * 33], s[5 * 33]); o.w = pk2(s[6 * 33], s[7 * 33]);
        *(u32x4*)(WT + (size_t)(n0 + n) * K + k0 + 8 * c) = o; }
    asm volatile("s_waitcnt lgkmcnt(0)" ::: "memory");
}

struct Args { const float* in[12]; float* out; unsigned char* ws; int ph_lo, ph_hi; };

__device__ __forceinline__ void prep_phase(const Args& a, LAS unsigned char* lds, int gw, int NGW, int wave, int lane) {
    unsigned char* ws = a.ws;
    LAS float* scr = (LAS float*)(lds + wave * 16384);
    const float* w_in = a.in[1]; const float* qn = a.in[2]; const float* kvn = a.in[3]; const float* w_uq = a.in[4]; const float* w_ukv = a.in[5]; const float* w_o = a.in[6];
    const float* w_kv = a.in[7]; const float* w_in2 = a.in[8]; const float* w_o2 = a.in[9];
    constexpr int I0 = 16 * 72, I1 = 12 * 48, I2 = 4 * 64, I3 = 16 * 32, I4 = 16 * 128, I5 = 16 * 32, NIT = I0 + I1 + I2 + I3 + I4 + I5;
    for (int it = gw; it < NIT; it += NGW) {
        int r = it; const int li = lane & 31;
        if (r < I0) { const int nb = r % 72, kb = r / 72, p = nb * 32 + li; const int sc = (p < 1024) ? p : (p < 2048) ? p + 32 : (p < 2080) ? p - 1024 : -1;
            transpose_item(w_in, 1024, 2080, (bf16*)(ws + WS_W1T), scr, kb * 64, nb * 32, sc, nullptr, lane); continue; } r -= I0;
        if (r < I1) { const int nb = r % 48, kb = r / 48; transpose_item(w_uq, 768, 1536, (bf16*)(ws + WS_WUQT), scr, kb * 64, nb * 32, nb * 32 + li, qn, lane); continue; } r -= I1;
        if (r < I2) { const int nb = r % 64, kb = r / 64, p = nb * 32 + li, pp = p & 1023; const int sc = (pp >> 6) * 128 + ((p >= 1024) ? 64 : 0) + (pp & 63);
            transpose_item(w_ukv, 256, 2048, (bf16*)(ws + WS_WUKVT), scr, kb * 64, nb * 32, sc, kvn, lane); continue; } r -= I2;
        if (r < I3) { const int nb = r % 32, kb = r / 32; transpose_item(w_o, 1024, 1024, (bf16*)(ws + WS_WOT), scr, kb * 64, nb * 32, nb * 32 + li, nullptr, lane); continue; } r -= I3;
        if (r < I4) { const int nb = r % 128, kb = r / 128, p = nb * 32 + li, sect = p >> 10, pp = p & 1023;
            const float* src = (sect < 2) ? w_kv : w_in2;
            const int sc = (sect == 0 || sect == 2) ? ((pp & ~63) | swap45(pp & 63)) : 1024 + pp;
            transpose_item(src, 1024, 2048, (bf16*)(ws + WS_W5T), scr, kb * 64, nb * 32, sc, nullptr, lane); continue; } r -= I4;
        { const int nb = r % 32, kb = r / 32; transpose_item(w_o2, 1024, 1024, (bf16*)(ws + WS_WO2T), scr, kb * 64, nb * 32, nb * 32 + li, nullptr, lane); }
    }
    {
        const float* x = a.in[0]; bf16* xb = (bf16*)(ws + WS_XB);
        const size_t gt = (size_t)gw * 64 + lane, NTH = (size_t)NGW * 64;
        for (size_t i = gt; i < (size_t)MT * DMODEL / 8; i += NTH) {
            const f32x4 v0 = *(const f32x4*)(x + i * 8), v1 = *(const f32x4*)(x + i * 8 + 4);
            u32x4 o; o.x = pk2(v0[0], v0[1]); o.y = pk2(v0[2], v0[3]); o.z = pk2(v1[0], v1[1]); o.w = pk2(v1[2], v1[3]);
            *(u32x4*)(xb + i * 8) = o;
        }
    }
    {
        float* tab = (float*)(ws + WS_TAB);
        const int gt = gw * 64 + lane, NTH = NGW * 64;
        for (int i = gt; i < 2048 * 48; i += NTH) {
            int pos, fi; float ex; float* cp; float* sp;
            if (i < 2048 * 16) { pos = i >> 4; fi = i & 15; ex = (float)(2 * fi) / 32.0f; cp = tab + i; sp = tab + 2048 * 16 + i; }
            else { const int j = i - 2048 * 16; pos = j >> 5; fi = j & 31; ex = (float)(2 * fi) / 64.0f; cp = tab + 2048 * 32 + j; sp = tab + 2048 * 32 + 2048 * 32 + j; }
            const float inv = __builtin_amdgcn_exp2f(-ex * 13.287712379549449f);
            const float ang = (float)pos * inv;
            const double rev = (double)ang * 0.15915494309189535; const double fr = rev - __builtin_floor(rev);
            *cp = __builtin_amdgcn_cosf((float)fr); *sp = __builtin_amdgcn_sinf((float)fr);
        }
    }
}

__device__ __forceinline__ void ln_phase(const float* z, float* outf, bf16* outb, const float* __restrict__ g, const float* __restrict__ bt, int gw, int NGW, int lane) {
    f32x4 gg[4], bb[4];
#pragma unroll
    for (int j = 0; j < 4; ++j) { gg[j] = *(const f32x4*)(g + 4 * lane + 256 * j); bb[j] = *(const f32x4*)(bt + 4 * lane + 256 * j); }
    for (int m = gw; m < MT; m += NGW) {
        const f32x4* xr = (const f32x4*)(z + (size_t)m * DMODEL) + lane;
        f32x4 v[4]; float s = 0.f;
#pragma unroll
        for (int j = 0; j < 4; ++j) { v[j] = xr[64 * j]; s += (v[j][0] + v[j][1]) + (v[j][2] + v[j][3]); }
        const float mean = wave_sum(s) * (1.f / DMODEL); float s2 = 0.f;
#pragma unroll
        for (int j = 0; j < 4; ++j) { v[j] = v[j] - mean; s2 += (v[j][0] * v[j][0] + v[j][1] * v[j][1]) + (v[j][2] * v[j][2] + v[j][3] * v[j][3]); }
        const float rstd = 1.f / sqrtf(wave_sum(s2) * (1.f / DMODEL) + 1e-5f);
        f32x4* orow = (f32x4*)(outf + (size_t)m * DMODEL) + lane;
#pragma unroll
        for (int j = 0; j < 4; ++j) { const f32x4 o = v[j] * rstd * gg[j] + bb[j]; orow[64 * j] = o;
            if (outb) { u32x2 w; w.x = pk2(o[0], o[1]); w.y = pk2(o[2], o[3]); *(u32x2*)(outb + (size_t)m * DMODEL + 4 * lane + 256 * j) = w; } }
    }
}

__device__ __forceinline__ void kmean_phase(const bf16* __restrict__ K, float* kmean, int gw, int NGW, int lane) {
    for (int it = gw; it < NB * 8 * NHEAD; it += NGW) {
        const int h = it & 15, blk = (it >> 4) & 7, b = it >> 7;
        const bf16* kp = K + ((size_t)b * SEQ + blk * 256 + (lane >> 3)) * 1024 + h * 64 + (lane & 7) * 8;
        float acc[8];
#pragma unroll
        for (int j = 0; j < 8; ++j) acc[j] = 0.f;
#pragma unroll 4
        for (int p = 0; p < 32; ++p) { const bf16x8 v = *(const bf16x8*)(kp + (size_t)p * 8 * 1024);
#pragma unroll
            for (int j = 0; j < 8; ++j) acc[j] += bf2f(v[j]); }
#pragma unroll
        for (int j = 0; j < 8; ++j) { float s = acc[j]; s += __shfl_xor(s, 8); s += __shfl_xor(s, 16); s += __shfl_xor(s, 32); acc[j] = s * (1.0f / 256.0f); }
        if (lane < 8) { float* o = kmean + ((size_t)(b * NHEAD + h) * 8 + blk) * 64 + lane * 8;
            *(f32x4*)o = (f32x4){acc[0], acc[1], acc[2], acc[3]}; *(f32x4*)(o + 4) = (f32x4){acc[4], acc[5], acc[6], acc[7]}; }
    }
}

constexpr int NPHASE = 11;
__global__ void __launch_bounds__(NWAVES * 64, 2) mega_fwd(Args a) {
    extern __shared__ __attribute__((aligned(16))) unsigned char lds_raw[];
    LAS unsigned char* lds = (LAS unsigned char*)lds_raw;
    cg::grid_group grid = cg::this_grid();
    const int tid = threadIdx.x, lane = tid & 63, wave = __builtin_amdgcn_readfirstlane(tid >> 6);
    const int G = gridDim.x, bx = blockIdx.x;
    const int vcu = (G % 8 == 0) ? (bx % 8) * (G / 8) + bx / 8 : bx;
    const int gw = vcu * NWAVES + wave, NGW = G * NWAVES;
    unsigned char* ws = a.ws;
    bf16* W1T = (bf16*)(ws + WS_W1T); bf16* WUQT = (bf16*)(ws + WS_WUQT); bf16* WUKVT = (bf16*)(ws + WS_WUKVT); bf16* WOT = (bf16*)(ws + WS_WOT);
    bf16* W5T = (bf16*)(ws + WS_W5T); bf16* WO2T = (bf16*)(ws + WS_WO2T);
    float* tab = (float*)(ws + WS_TAB); const float* cosA = tab; const float* sinA = tab + 2048 * 16; const float* cosB = tab + 2048 * 32; const float* sinB = tab + 2048 * 64;
    float* kmean = (float*)(ws + WS_KMEAN); float* ssq = (float*)(ws + WS_SSQ); bf16* KROPE = (bf16*)(ws + WS_KROPE);
    bf16* XB = (bf16*)(ws + WS_XB); bf16* CQ = (bf16*)(ws + WS_CQ); bf16* CKV = (bf16*)(ws + WS_CKV); bf16* GATE = (bf16*)(ws + WS_GATE);
    bf16* QB = (bf16*)(ws + WS_Q); bf16* KB = (bf16*)(ws + WS_K); bf16* VB = (bf16*)(ws + WS_V);
    const int lo = a.ph_lo, hi = a.ph_hi;
#define IN(k) (lo <= (k) && (k) < hi)
#define SEAM(k) do { if (IN(k) && IN((k) + 1)) grid.sync(); } while (0)

    if (IN(0)) prep_phase(a, lds, gw, NGW, wave, lane);
    SEAM(0);
    if (IN(1)) {
        pg8::Gemm g{XB, W1T, MT, 2304, 1024}; pg8::StaticOrder S; S.init(MT, 2304, G, bx);
        pg8::Epi1 E{CQ, CKV, GATE, KROPE, ssq, cosA, sinA};
        pg8::gemm_phase<pg8::Epi1, pg8::StaticOrder, true, true>(lds, g, S, E);
    }
    SEAM(1);
    if (IN(2)) {
        { pg8::Gemm g{CQ, WUQT, MT, 1536, 768}; pg8::StaticOrder S; S.init(MT, 1536, G, bx);
          pg8::Epi2 E{QB, ssq, cosA, sinA, QS_A};
          pg8::gemm_phase<pg8::Epi2, pg8::StaticOrder, true, true>(lds, g, S, E); }
        { pg8::Gemm g{CKV, WUKVT, MT, 2048, 256}; pg8::StaticOrder S; S.init(MT, 2048, G, bx);
          pg8::Epi3 E{KB, VB, ssq};
          pg8::gemm_phase<pg8::Epi3, pg8::StaticOrder, true, true>(lds, g, S, E); }
    }
    SEAM(2);
    if (IN(3)) {
        for (int bh = vcu; bh < NB * NHEAD; bh += G)
            for (int qb = 7; qb >= 0; --qb) attn_unit<96, false>(lds, bh >> 4, bh & 15, qb, QB, 1536, KB, KROPE, VB, GATE, nullptr);
    }
    SEAM(3);
    if (IN(4)) {
        pg8::Gemm g{GATE, WOT, MT, 1024, 1024}; pg8::StaticOrder S; S.init(MT, 1024, G, bx);
        pg8::Epi4 E{a.in[0], a.out, ALPHA};
        pg8::gemm_phase<pg8::Epi4, pg8::StaticOrder, true, true>(lds, g, S, E);
    }
    SEAM(4);
    if (IN(5)) ln_phase(a.out, a.out, XB, a.in[10], a.in[11], gw, NGW, lane);
    SEAM(5);
    if (IN(6)) {
        pg8::Gemm g{XB, W5T, MT, 4096, 1024}; pg8::StaticOrder S; S.init(MT, 4096, G, bx);
        pg8::Epi5 E{KB, VB, QB, GATE, cosB, sinB, QS_B};
        pg8::gemm_phase<pg8::Epi5, pg8::StaticOrder, true, true>(lds, g, S, E);
    }
    SEAM(6);
    if (IN(7)) kmean_phase(KB, kmean, gw, NGW, lane);
    SEAM(7);
    if (IN(8)) {
        for (int bh = vcu; bh < NB * NHEAD; bh += G)
            for (int qb = 7; qb >= 0; --qb) attn_unit<64, true>(lds, bh >> 4, bh & 15, qb, QB, 1024, KB, nullptr, VB, GATE, kmean);
    }
    SEAM(8);
    if (IN(9)) {
        pg8::Gemm g{GATE, WO2T, MT, 1024, 1024}; pg8::StaticOrder S; S.init(MT, 1024, G, bx);
        pg8::Epi4 E{a.out, a.out, ALPHA};
        pg8::gemm_phase<pg8::Epi4, pg8::StaticOrder, true, true>(lds, g, S, E);
    }
    SEAM(9);
    if (IN(10)) ln_phase(a.out, a.out, nullptr, a.in[10] + 1024, a.in[11] + 1024, gw, NGW, lane);
#undef IN
#undef SEAM
}

#ifndef MK_PER_PHASE
#define MK_PER_PHASE 0
#endif
extern "C" void kernel_launch(void* const* d_in, const int* in_sizes, int n_in, void* d_out, int out_size, void* d_ws, size_t ws_size, hipStream_t stream) {
    static int grid = 0;
    if (grid == 0) {
        if (n_in != 12 || out_size != MT * DMODEL || ws_size < WS_END) { fprintf(stderr, "kernel_launch: unexpected shapes (n_in %d out %d ws %zu)\n", n_in, out_size, ws_size); grid = -1; return; }
        int dev = 0, cus = 0, per_cu = 0;
        hipGetDevice(&dev); hipDeviceGetAttribute(&cus, hipDeviceAttributeMultiprocessorCount, dev);
        if (hipFuncSetAttribute((const void*)mega_fwd, hipFuncAttributeMaxDynamicSharedMemorySize, LDS_BYTES) != hipSuccess) { fprintf(stderr, "hipFuncSetAttribute failed\n"); grid = -1; return; }
        if (hipOccupancyMaxActiveBlocksPerMultiprocessor(&per_cu, (const void*)mega_fwd, NWAVES * 64, LDS_BYTES) != hipSuccess || per_cu < 1) { fprintf(stderr, "occupancy query: %d\n", per_cu); per_cu = 1; }
        (void)hipGetLastError();
        grid = cus;
    }
    if (grid < 0) return;
    Args a{};
    for (int i = 0; i < 12; ++i) a.in[i] = (const float*)d_in[i];
    a.out = (float*)d_out; a.ws = (unsigned char*)d_ws;
#if MK_PER_PHASE
    for (int p = 0; p < NPHASE; ++p) { a.ph_lo = p; a.ph_hi = p + 1; hipLaunchKernelGGL(mega_fwd, dim3(grid), dim3(NWAVES * 64), LDS_BYTES, stream, a); }
#else
    a.ph_lo = 0; a.ph_hi = NPHASE;
    void* args[] = {&a};
    hipError_t e = hipLaunchCooperativeKernel((const void*)mega_fwd, dim3(grid), dim3(NWAVES * 64), args, LDS_BYTES, stream);
    if (e != hipSuccess) fprintf(stderr, "cooperative launch failed: %s (grid %d)\n", hipGetErrorString(e), grid);
#endif
}
```

```cpp
#include <hip/hip_runtime.h>
#include <hip/hip_cooperative_groups.h>
#include <cstdio>
#include <cstdint>
namespace cg = cooperative_groups;
namespace pg8 {
#define PG8_LAS __attribute__((address_space(3)))
typedef unsigned short bf16_t;
typedef short bf16x8 __attribute__((ext_vector_type(8)));
typedef float f32x4 __attribute__((ext_vector_type(4)));
typedef unsigned u32x4 __attribute__((ext_vector_type(4)));
constexpr int BM = 256, BK = 64, HALF = 128, HTB = HALF * BK * 2  , STAGE_BYTES = 8 * HTB, NXCD = 8, WGM = 8;

__host__ __device__ __forceinline__ int lds_byte(int r, int c) { const int st = (r >> 4) * 2 + (c >> 5), rr = r & 15, cc = c & 31, ob = rr * 64 + cc * 2; return st * 1024 + (ob ^ (((ob >> 9) & 1) << 5)); }
__host__ __device__ __forceinline__ void stage_rc(int b, int& R, int& C) { const int st = b / 1024, sb = b % 1024, swz = sb ^ (((sb >> 9) & 1) << 5); R = (st >> 1) * 16 + swz / 64; C = (st & 1) * 32 + (swz % 64) / 2; }
__host__ __device__ __forceinline__ int perm32(int rho) { const int n = rho >> 4, i = rho & 15; return 8 * (i >> 2) + 4 * n + (i & 3); }

struct Unit { int pm, pn; };
struct Gemm { const bf16_t* A; const bf16_t* Bt; int M, N, K; };

struct StaticOrder {
    int nM, nN, nwg, G, c;
    __host__ __device__ void init(int M, int N, int G_, int c_) { nM = M / BM; nN = N / BM; nwg = nM * nN; G = G_; c = c_; }
    __host__ __device__ bool next(int i, Unit& u) const {
        const long L = (long)i * G + c; if (L >= nwg) return false;
        int wgid = (int)L; { const int q = nwg / NXCD, r = nwg % NXCD, xcd = wgid % NXCD, off = wgid / NXCD; wgid = (xcd < r ? xcd * (q + 1) : r * (q + 1) + (xcd - r) * q) + off; }
        const int nig = WGM * nN, gid = wgid / nig, fm = gid * WGM, gsz = (nM - fm) < WGM ? (nM - fm) : WGM;
        u.pm = fm + ((wgid % nig) % gsz); u.pn = (wgid % nig) / gsz; return true;
    }
    __device__ __forceinline__ void a_ready(const Unit&) const {}
    __device__ __forceinline__ void done(const Unit&) const {}
};

__device__ __forceinline__ unsigned cvt_pk_bf16(float lo, float hi) { unsigned r; asm volatile("v_cvt_pk_bf16_f32 %0, %1, %2" : "=v"(r) : "v"(lo), "v"(hi)); return r; }
typedef unsigned u32x2 __attribute__((ext_vector_type(2)));
__device__ __forceinline__ void st_bf16x4(bf16_t* p, f32x4 v) { u32x2 w; w.x = cvt_pk_bf16(v[0], v[1]); w.y = cvt_pk_bf16(v[2], v[3]); *(u32x2*)p = w; }
__device__ __forceinline__ float silu_f(float v) { return v * __builtin_amdgcn_rcpf(1.0f + __builtin_amdgcn_exp2f(-1.4426950408889634f * v)); }
__device__ __forceinline__ f32x4 silu4(f32x4 v) { return (f32x4){silu_f(v[0]), silu_f(v[1]), silu_f(v[2]), silu_f(v[3])}; }


struct Epi1 {
    static constexpr bool PERM = false, AFTER_DRAIN = false;
    bf16_t* cq; bf16_t* ckv; bf16_t* gate; bf16_t* krope; float* ssq; const float* cosA; const float* sinA;
    __device__ __forceinline__ void operator()(const f32x4 (&acc)[2][2][4][2], const Unit& u, int wr, int wc, int fr, int fq) const {
        const int pn = u.pn;
#pragma unroll
        for (int ai = 0; ai < 2; ++ai)
#pragma unroll
            for (int m = 0; m < 4; ++m) {
                const int row = u.pm * BM + ai * HALF + wr * 64 + m * 16 + fr;
                if (pn < 4) {
                    float s = 0.f;
                    bf16_t* dst = (pn < 3) ? cq + (size_t)row * 768 + pn * 256 : ckv + (size_t)row * 256;
#pragma unroll
                    for (int bj = 0; bj < 2; ++bj)
#pragma unroll
                        for (int n = 0; n < 2; ++n) { const f32x4 v = acc[ai][bj][m][n]; s += (v[0] * v[0] + v[1] * v[1]) + (v[2] * v[2] + v[3] * v[3]);
                            st_bf16x4(dst + bj * HALF + wc * 32 + n * 16 + 4 * fq, v); }
                    s += __shfl_xor(s, 16); s += __shfl_xor(s, 32);
                    if (fq == 0) ssq[(size_t)row * 16 + pn * 4 + wc] = s;
                } else if (pn < 8) {
                    bf16_t* dst = gate + (size_t)row * 1024 + (pn - 4) * 256;
#pragma unroll
                    for (int bj = 0; bj < 2; ++bj)
#pragma unroll
                        for (int n = 0; n < 2; ++n) st_bf16x4(dst + bj * HALF + wc * 32 + n * 16 + 4 * fq, silu4(acc[ai][bj][m][n]));
                } else if (wc == 0) {
                    const int pos = row & 2047;
                    const f32x4 c = *(const f32x4*)(cosA + pos * 16 + 4 * fq), sn = *(const f32x4*)(sinA + pos * 16 + 4 * fq);
                    const f32x4 v0 = acc[ai][0][m][0], v1 = acc[ai][0][m][1];
                    st_bf16x4(krope + (size_t)row * 32 + 4 * fq, v0 * c - v1 * sn);
                    st_bf16x4(krope + (size_t)row * 32 + 16 + 4 * fq, v1 * c + v0 * sn);
                }
            }
    }
};
struct Epi2 {
    static constexpr bool PERM = false, AFTER_DRAIN = false;
    bf16_t* Q; const float* ssq; const float* cosA; const float* sinA; float qs;
    __device__ __forceinline__ void operator()(const f32x4 (&acc)[2][2][4][2], const Unit& u, int wr, int wc, int fr, int fq) const {
#pragma unroll
        for (int ai = 0; ai < 2; ++ai)
#pragma unroll
            for (int m = 0; m < 4; ++m) {
                const int row = u.pm * BM + ai * HALF + wr * 64 + m * 16 + fr;
                const f32x4* sp = (const f32x4*)(ssq + (size_t)row * 16);
                const f32x4 s0 = sp[0], s1 = sp[1], s2 = sp[2];
                const float t = ((s0[0] + s0[1]) + (s0[2] + s0[3])) + ((s1[0] + s1[1]) + (s1[2] + s1[3])) + ((s2[0] + s2[1]) + (s2[2] + s2[3]));
                const float sc = qs / sqrtf(t * (1.0f / 768.0f) + 1e-6f);
                const int pos = row & 2047;
                bf16_t* dst = Q + (size_t)row * 1536 + u.pn * 256 + wc * 32 + 4 * fq;
#pragma unroll
                for (int bj = 0; bj < 2; ++bj) {
                    const int g = u.pn * 8 + bj * 4 + wc;
                    const f32x4 v0 = acc[ai][bj][m][0] * sc, v1 = acc[ai][bj][m][1] * sc;
                    if (g % 3 == 2) {
                        const f32x4 c = *(const f32x4*)(cosA + pos * 16 + 4 * fq), sn = *(const f32x4*)(sinA + pos * 16 + 4 * fq);
                        st_bf16x4(dst + bj * HALF, v0 * c - v1 * sn); st_bf16x4(dst + bj * HALF + 16, v1 * c + v0 * sn);
                    } else { st_bf16x4(dst + bj * HALF, v0); st_bf16x4(dst + bj * HALF + 16, v1); }
                }
            }
    }
};
struct Epi3 {
    static constexpr bool PERM = false, AFTER_DRAIN = false;
    bf16_t* K; bf16_t* V; const float* ssq;
    __device__ __forceinline__ void operator()(const f32x4 (&acc)[2][2][4][2], const Unit& u, int wr, int wc, int fr, int fq) const {
#pragma unroll
        for (int ai = 0; ai < 2; ++ai)
#pragma unroll
            for (int m = 0; m < 4; ++m) {
                const int row = u.pm * BM + ai * HALF + wr * 64 + m * 16 + fr;
                const f32x4 s3 = *(const f32x4*)(ssq + (size_t)row * 16 + 12);
                const float sc = 1.0f / sqrtf(((s3[0] + s3[1]) + (s3[2] + s3[3])) * (1.0f / 256.0f) + 1e-6f);
                bf16_t* dst = ((u.pn < 4) ? K : V) + (size_t)row * 1024 + (u.pn & 3) * 256 + wc * 32 + 4 * fq;
#pragma unroll
                for (int bj = 0; bj < 2; ++bj)
#pragma unroll
                    for (int n = 0; n < 2; ++n) st_bf16x4(dst + bj * HALF + n * 16, acc[ai][bj][m][n] * sc);
            }
    }
};
struct Epi4 {
    static constexpr bool PERM = false, AFTER_DRAIN = false;
    const float* res; float* out; float alpha;
    __device__ __forceinline__ void operator()(const f32x4 (&acc)[2][2][4][2], const Unit& u, int wr, int wc, int fr, int fq) const {
#pragma unroll
        for (int ai = 0; ai < 2; ++ai)
#pragma unroll
            for (int m = 0; m < 4; ++m) {
                const size_t off = (size_t)(u.pm * BM + ai * HALF + wr * 64 + m * 16 + fr) * 1024 + u.pn * 256 + wc * 32 + 4 * fq;
#pragma unroll
                for (int bj = 0; bj < 2; ++bj)
#pragma unroll
                    for (int n = 0; n < 2; ++n) { const f32x4 r = *(const f32x4*)(res + off + bj * HALF + n * 16); *(f32x4*)(out + off + bj * HALF + n * 16) = r * alpha + acc[ai][bj][m][n]; }
            }
    }
};
struct Epi5 {
    static constexpr bool PERM = false, AFTER_DRAIN = false;
    bf16_t* K; bf16_t* V; bf16_t* Q; bf16_t* gate; const float* cosB; const float* sinB; float qs;
    __device__ __forceinline__ void operator()(const f32x4 (&acc)[2][2][4][2], const Unit& u, int wr, int wc, int fr, int fq) const {
        const int sect = u.pn >> 2, pq = u.pn & 3;
#pragma unroll
        for (int ai = 0; ai < 2; ++ai)
#pragma unroll
            for (int m = 0; m < 4; ++m) {
                const int row = u.pm * BM + ai * HALF + wr * 64 + m * 16 + fr;
                if (sect == 0 || sect == 2) {
                    const int pos = row & 2047, d1 = 16 * (wc & 1) + 4 * fq;
                    const f32x4 c = *(const f32x4*)(cosB + pos * 32 + d1), sn = *(const f32x4*)(sinB + pos * 32 + d1);
                    const float sc = (sect == 2) ? qs : 1.0f;
                    bf16_t* dst = ((sect == 0) ? K : Q) + (size_t)row * 1024 + pq * 256 + (wc >> 1) * 64 + d1;
#pragma unroll
                    for (int bj = 0; bj < 2; ++bj) { const f32x4 v0 = acc[ai][bj][m][0] * sc, v1 = acc[ai][bj][m][1] * sc;
                        st_bf16x4(dst + bj * HALF, v0 * c - v1 * sn); st_bf16x4(dst + bj * HALF + 32, v1 * c + v0 * sn); }
                } else {
                    bf16_t* dst = ((sect == 1) ? V : gate) + (size_t)row * 1024 + pq * 256 + wc * 32 + 4 * fq;
#pragma unroll
                    for (int bj = 0; bj < 2; ++bj)
#pragma unroll
                        for (int n = 0; n < 2; ++n) st_bf16x4(dst + bj * HALF + n * 16, (sect == 1) ? acc[ai][bj][m][n] : silu4(acc[ai][bj][m][n]));
                }
            }
    }
};

template <class Epi, class Sched, bool ALIGN_EPI = false, bool SP2 = false>
__device__ __forceinline__ void gemm_phase(PG8_LAS unsigned char* lds, const Gemm g, const Sched& S, const Epi& E) {
    const int tid = threadIdx.x, wid = __builtin_amdgcn_readfirstlane(tid >> 6), lane = tid & 63, wr = wid >> 2, wc = wid & 3, fr = lane & 15, fq = lane >> 4;
    const int K = g.K, nt = K / BK;
    unsigned voffA[2], voffB[2];
#pragma unroll
    for (int i = 0; i < 2; ++i) { int R, C; stage_rc(tid * 16 + i * 8192, R, C); const int Rb = Epi::PERM ? ((R & ~31) + perm32(R & 31)) : R;
        voffA[i] = (unsigned)(R * K + C) * 2u; voffB[i] = (unsigned)(Rb * K + C) * 2u; }
    const size_t kstep = (size_t)(BK * 2);
    const size_t hstep = (size_t)HALF * K * 2;
    const size_t tstep = 2 * hstep;
    const unsigned ldsw = (unsigned)wid * 1024u;
    const int aoff = lds_byte(wr * 64 + fr, fq * 8), boff = lds_byte(wc * 32 + fr, fq * 8);
#define PG8_SA(b, h) (((b) * 2 + (h)) * HTB)
#define PG8_SB(b, h) ((4 + (b) * 2 + (h)) * HTB)
#define PG8_STAGE(bufoff, gbase, voff) do { _Pragma("unroll") for (int _i = 0; _i < 2; ++_i) \
        __builtin_amdgcn_global_load_lds((const unsigned*)((const char*)(gbase) + (voff)[_i]), (PG8_LAS unsigned*)(lds + (bufoff) + ldsw + _i * 8192), 16, 0, 0); } while (0)
#define PG8_LDA(dst, b, h) do { _Pragma("unroll") for (int m = 0; m < 4; ++m) _Pragma("unroll") for (int k = 0; k < 2; ++k) dst[m][k] = *(const PG8_LAS bf16x8*)(lds + PG8_SA(b, h) + aoff + m * 2048 + k * 1024); } while (0)
#define PG8_LDB(dst, b, h) do { _Pragma("unroll") for (int n = 0; n < 2; ++n) _Pragma("unroll") for (int k = 0; k < 2; ++k) dst[n][k] = *(const PG8_LAS bf16x8*)(lds + PG8_SB(b, h) + boff + n * 2048 + k * 1024); } while (0)
#define PG8_MMA(ai, bj, At, Bt) do { __builtin_amdgcn_s_setprio(1); _Pragma("unroll") for (int m = 0; m < 4; ++m) _Pragma("unroll") for (int n = 0; n < 2; ++n) _Pragma("unroll") for (int k = 0; k < 2; ++k) \
        acc[ai][bj][m][n] = __builtin_amdgcn_mfma_f32_16x16x32_bf16(Bt[n][k], At[m][k], acc[ai][bj][m][n], 0, 0, 0); __builtin_amdgcn_s_setprio(0); } while (0)
#define PG8_WAIT_V(n) asm volatile("s_waitcnt vmcnt(" #n ")" ::: "memory")
#define PG8_WAIT_L(n) asm volatile("s_waitcnt lgkmcnt(" #n ")" ::: "memory")
#define PG8_BAR __builtin_amdgcn_s_barrier()
#define PG8_SCHED __builtin_amdgcn_sched_barrier(0)
    Unit cur, nxt; int ui = 0;
    if (!S.next(0, cur)) return;
    f32x4 acc[2][2][4][2];
#pragma unroll
    for (int a = 0; a < 2; ++a)
#pragma unroll
        for (int b = 0; b < 2; ++b)
#pragma unroll
            for (int m = 0; m < 4; ++m)
#pragma unroll
                for (int n = 0; n < 2; ++n) acc[a][b][m][n] = (f32x4){0.f, 0.f, 0.f, 0.f};
    bf16x8 At[4][2], B0[2][2], B1[2][2];
    const char* cA = (const char*)g.A + (size_t)cur.pm * tstep; const char* cB = (const char*)g.Bt + (size_t)cur.pn * tstep;
    S.a_ready(cur);
    if constexpr (SP2) {
        PG8_STAGE(PG8_SB(0, 0), cB, voffB); PG8_STAGE(PG8_SB(0, 1), cB + hstep, voffB); PG8_STAGE(PG8_SA(0, 0), cA, voffA); PG8_STAGE(PG8_SA(0, 1), cA + hstep, voffA);
        if (wr == 1) PG8_BAR;
        PG8_WAIT_V(2); PG8_BAR;
        PG8_STAGE(PG8_SB(1, 0), cB + kstep, voffB); PG8_STAGE(PG8_SA(1, 0), cA + kstep, voffA); PG8_STAGE(PG8_SB(1, 1), cB + hstep + kstep, voffB);
        PG8_WAIT_V(6); PG8_BAR;
    } else {
        PG8_STAGE(PG8_SB(0, 0), cB, voffB); PG8_STAGE(PG8_SA(0, 0), cA, voffA); PG8_STAGE(PG8_SB(0, 1), cB + hstep, voffB); PG8_STAGE(PG8_SA(0, 1), cA + hstep, voffA);
        if (wr == 1) PG8_BAR;
        PG8_WAIT_V(4); PG8_BAR;
        PG8_STAGE(PG8_SB(1, 0), cB + kstep, voffB); PG8_STAGE(PG8_SA(1, 0), cA + kstep, voffA); PG8_STAGE(PG8_SB(1, 1), cB + hstep + kstep, voffB);
        PG8_WAIT_V(6); PG8_BAR;
    }
    for (;;) {
        const bool has_next = S.next(ui + 1, nxt);
        const char* nA = has_next ? (const char*)g.A + (size_t)nxt.pm * tstep : cA; const char* nB = has_next ? (const char*)g.Bt + (size_t)nxt.pn * tstep : cB;
        for (int t = 0; t < nt; t += 2) {
            const bool last = (t == nt - 2);
            const char* a1 = cA + (size_t)(t + 1) * kstep;
            const char* a2 = last ? nA : cA + (size_t)(t + 2) * kstep; const char* b2 = last ? nB : cB + (size_t)(t + 2) * kstep;
            const char* a3 = a2 + kstep; const char* b3 = b2 + kstep;
            if (last && has_next) S.a_ready(nxt);
            if constexpr (SP2) {
            PG8_LDB(B0, 0, 0); PG8_LDB(B1, 0, 1); PG8_SCHED; PG8_LDA(At, 0, 0); PG8_STAGE(PG8_SA(1, 1), a1 + hstep, voffA);
            PG8_WAIT_V(8); PG8_WAIT_L(0); PG8_BAR; PG8_MMA(0, 0, At, B0); PG8_MMA(0, 1, At, B1); PG8_BAR; PG8_SCHED;
            PG8_LDA(At, 0, 1); PG8_STAGE(PG8_SB(0, 0), b2, voffB); PG8_STAGE(PG8_SB(0, 1), b2 + hstep, voffB); PG8_STAGE(PG8_SA(0, 0), a2, voffA);
            PG8_WAIT_V(8); PG8_WAIT_L(0); PG8_BAR; PG8_MMA(1, 0, At, B0); PG8_MMA(1, 1, At, B1); PG8_BAR; PG8_SCHED;
            PG8_LDB(B0, 1, 0); PG8_LDB(B1, 1, 1); PG8_SCHED; PG8_LDA(At, 1, 0); PG8_STAGE(PG8_SA(0, 1), a2 + hstep, voffA);
            PG8_WAIT_V(8); PG8_WAIT_L(0); PG8_BAR; PG8_MMA(0, 0, At, B0); PG8_MMA(0, 1, At, B1); PG8_BAR; PG8_SCHED;
            PG8_LDA(At, 1, 1); PG8_STAGE(PG8_SB(1, 0), b3, voffB); PG8_STAGE(PG8_SB(1, 1), b3 + hstep, voffB); PG8_STAGE(PG8_SA(1, 0), a3, voffA);
            PG8_WAIT_V(8); PG8_WAIT_L(0); PG8_BAR; PG8_MMA(1, 0, At, B0); PG8_MMA(1, 1, At, B1); PG8_BAR; PG8_SCHED;
            } else {
            PG8_LDB(B0, 0, 0); PG8_SCHED; PG8_LDA(At, 0, 0); PG8_STAGE(PG8_SA(1, 1), a1 + hstep, voffA);
            PG8_WAIT_L(8); PG8_BAR; PG8_WAIT_L(0); PG8_MMA(0, 0, At, B0); PG8_BAR; PG8_SCHED;
            PG8_LDB(B1, 0, 1); PG8_STAGE(PG8_SB(0, 0), b2, voffB);
            PG8_BAR; PG8_WAIT_L(0); PG8_MMA(0, 1, At, B1); PG8_BAR;
            PG8_LDA(At, 0, 1); PG8_STAGE(PG8_SA(0, 0), a2, voffA);
            PG8_BAR; PG8_WAIT_L(0); PG8_MMA(1, 0, At, B0); PG8_BAR; PG8_SCHED;
            PG8_STAGE(PG8_SB(0, 1), b2 + hstep, voffB);
            PG8_WAIT_V(6); PG8_BAR; PG8_MMA(1, 1, At, B1); PG8_BAR;
            PG8_LDB(B0, 1, 0); PG8_SCHED; PG8_LDA(At, 1, 0); PG8_STAGE(PG8_SA(0, 1), a2 + hstep, voffA);
            PG8_WAIT_L(8); PG8_BAR; PG8_WAIT_L(0); PG8_MMA(0, 0, At, B0); PG8_BAR; PG8_SCHED;
            PG8_LDB(B1, 1, 1); PG8_STAGE(PG8_SB(1, 0), b3, voffB);
            PG8_BAR; PG8_WAIT_L(0); PG8_MMA(0, 1, At, B1); PG8_BAR;
            PG8_LDA(At, 1, 1); PG8_STAGE(PG8_SA(1, 0), a3, voffA);
            PG8_BAR; PG8_WAIT_L(0); PG8_MMA(1, 0, At, B0); PG8_BAR; PG8_SCHED;
            PG8_STAGE(PG8_SB(1, 1), b3 + hstep, voffB);
            PG8_WAIT_V(6); PG8_BAR; PG8_MMA(1, 1, At, B1); PG8_BAR;
            }
        }
        if constexpr (ALIGN_EPI) { if (wr == 0) PG8_BAR; }
        if constexpr (!Epi::AFTER_DRAIN) { E(acc, cur, wr, wc, fr, fq); S.done(cur); }
        if (!has_next) break;
#pragma unroll
        for (int a = 0; a < 2; ++a)
#pragma unroll
            for (int b = 0; b < 2; ++b)
#pragma unroll
                for (int m = 0; m < 4; ++m)
#pragma unroll
                    for (int n = 0; n < 2; ++n) acc[a][b][m][n] = (f32x4){0.f, 0.f, 0.f, 0.f};
        cur = nxt; cA = nA; cB = nB; ++ui;
        if constexpr (ALIGN_EPI) { if (wr == 1) PG8_BAR; }
    }
    PG8_WAIT_V(0);
    if constexpr (!ALIGN_EPI) { if (wr == 0) PG8_BAR; }
    PG8_BAR;
    if constexpr (Epi::AFTER_DRAIN) { E.fused(acc, cur, wr, wc, fr, fq, lds, wid, lane); S.done(cur); }
#undef PG8_SA
#undef PG8_SB
#undef PG8_STAGE
#undef PG8_LDA
#undef PG8_LDB
#undef PG8_MMA
#undef PG8_WAIT_V
#undef PG8_WAIT_L
#undef PG8_BAR
#undef PG8_SCHED
}
}

#define LAS __attribute__((address_space(3)))
typedef unsigned short bf16;
typedef short bf16x8 __attribute__((ext_vector_type(8)));
typedef short s16x4 __attribute__((ext_vector_type(4)));
typedef float f32x4 __attribute__((ext_vector_type(4)));
typedef float f32x16 __attribute__((ext_vector_type(16)));
typedef unsigned u32x4 __attribute__((ext_vector_type(4)));
typedef unsigned u32x2 __attribute__((ext_vector_type(2)));

constexpr int NB = 16, SEQ = 2048, DMODEL = 1024, MT = NB * SEQ, NHEAD = 16;
constexpr float ALPHA = 1.4142135623730951f;
constexpr float LOG2E = 1.4426950408889634f;
constexpr float QS_A = 0.10206207261596575f * LOG2E;
constexpr float QS_B = 0.125f * LOG2E;
constexpr size_t MiB = 1u << 20;
constexpr size_t WS_W1T = 0, WS_WUQT = 5 * MiB, WS_WUKVT = 8 * MiB, WS_WOT = 9 * MiB, WS_W5T = 11 * MiB, WS_WO2T = 19 * MiB;
constexpr size_t WS_TAB = 21 * MiB, WS_KMEAN = 22 * MiB, WS_SSQ = 23 * MiB, WS_KROPE = 25 * MiB;
constexpr size_t WS_XB = 32 * MiB, WS_CQ = 96 * MiB, WS_CKV = 144 * MiB, WS_GATE = 160 * MiB, WS_Q = 224 * MiB, WS_K = 320 * MiB, WS_V = 384 * MiB, WS_END = 448 * MiB;
constexpr size_t WS_BAR = 21 * MiB + 768 * 1024, BAR_BYTES = 16384;
constexpr int LDS_BYTES = 131072 + 1024, LDS_BARST = 131072;
constexpr int NWAVES = 8;

__device__ __forceinline__ float bf2f(short s) { return __uint_as_float(((unsigned)(unsigned short)s) << 16); }
__device__ __forceinline__ unsigned f2bf(float f) { unsigned u = __builtin_bit_cast(unsigned, f); return (u + 0x7fffu + ((u >> 16) & 1u)) >> 16; }
__device__ __forceinline__ unsigned pk2(float lo, float hi) { return f2bf(lo) | (f2bf(hi) << 16); }
__device__ __forceinline__ unsigned cvtpk(float lo, float hi) { unsigned r; asm volatile("v_cvt_pk_bf16_f32 %0, %1, %2" : "=v"(r) : "v"(lo), "v"(hi)); return r; }
__device__ __forceinline__ float wave_sum(float v) {
#pragma unroll
    for (int o = 1; o < 64; o <<= 1) v += __shfl_xor(v, o);
    return v;
}

__device__ __forceinline__ int crow(int r, int hi) { return (r & 3) + 8 * (r >> 2) + 4 * hi; }
typedef short v4i16_t __attribute__((ext_vector_type(4)));
__device__ __forceinline__ s16x4 vtr(const LAS unsigned char* p) { return __builtin_bit_cast(s16x4, __builtin_amdgcn_ds_read_tr16_b64_v4i16((LAS v4i16_t*)p)); }

__device__ __forceinline__ void glds16(const void* gsrc, unsigned lds_dst) { unsigned keep;
    asm volatile("s_mov_b32 %0, m0\n\ts_mov_b32 m0, %2\n\ts_nop 0\n\tglobal_load_lds_dwordx4 %1, off\n\ts_mov_b32 m0, %0" : "=&s"(keep) : "v"(gsrc), "s"(lds_dst) : "memory"); }
#define ATT_WAIT_BAR(N) asm volatile("s_waitcnt vmcnt(" #N ") lgkmcnt(0)\n\ts_barrier" ::: "memory")
#define ATT_SBAR() __builtin_amdgcn_sched_barrier(0)

__device__ __forceinline__ float max3_s(float a, float b, float c) { float r; asm("v_max3_f32 %0, %1, %2, %3" : "=v"(r) : "v"(a), "v"(b), "v"(c)); return r; }
__device__ __forceinline__ float max2_s(float a, float b) { float r; asm("v_max_f32_e32 %0, %1, %2" : "=v"(r) : "v"(a), "v"(b)); return r; }
__device__ __forceinline__ float add_s(float a, float b) { float r; asm("v_add_f32_e32 %0, %1, %2" : "=v"(r) : "v"(a), "v"(b)); return r; }
template <int NKS>
__device__ __forceinline__ void attn_qk(f32x16& p0, f32x16& p1, const f32x16& c, const bf16x8 (&qr)[NKS], const LAS unsigned char* ka) {
    {   bf16x8 kf[NKS];
#pragma unroll
        for (int ks = 0; ks < NKS; ++ks) kf[ks] = *(const LAS bf16x8*)(ka + ks * 2048);
        p0 = __builtin_amdgcn_mfma_f32_32x32x16_bf16(kf[0], qr[0], c, 0, 0, 0);
#pragma unroll
        for (int ks = 1; ks < NKS; ++ks) p0 = __builtin_amdgcn_mfma_f32_32x32x16_bf16(kf[ks], qr[ks], p0, 0, 0, 0); }
    {   bf16x8 kf[NKS];
#pragma unroll
        for (int ks = 0; ks < NKS; ++ks) kf[ks] = *(const LAS bf16x8*)(ka + ks * 2048 + 512);
        p1 = __builtin_amdgcn_mfma_f32_32x32x16_bf16(kf[0], qr[0], c, 0, 0, 0);
#pragma unroll
        for (int ks = 1; ks < NKS; ++ks) p1 = __builtin_amdgcn_mfma_f32_32x32x16_bf16(kf[ks], qr[ks], p1, 0, 0, 0); }
}
__device__ __forceinline__ void attn_band_mask(f32x16& p0, f32x16& p1, int bt, int wid, int r32, int hi) {
    const int thr = 32 * wid + r32 - 64 * bt - 4 * hi;
#pragma unroll
    for (int r = 0; r < 16; ++r) { if (((r & 3) + 8 * (r >> 2)) > thr) p0[r] = -INFINITY; if (((r & 3) + 8 * (r >> 2)) + 32 > thr) p1[r] = -INFINITY; }
}
template <int NKS, int MODE>
__device__ __forceinline__ void attn_h1(f32x16& p0, f32x16& p1, const f32x16& negm, const bf16x8 (&qr)[NKS], const LAS unsigned char* kb, int arg, int wid, int r32, int hi, unsigned sel) {
    ATT_SBAR();
    const LAS unsigned char* ka = kb + hi * 1024 + r32 * 16;
    if (MODE == 2) {
        const bool on = ((sel >> arg) & 1u) != 0u;
        f32x16 cm;
#pragma unroll
        for (int r = 0; r < 16; ++r) cm[r] = on ? negm[r] : -INFINITY;
        attn_qk<NKS>(p0, p1, cm, qr, ka);
    } else {
        attn_qk<NKS>(p0, p1, negm, qr, ka);
        if (MODE == 1) attn_band_mask(p0, p1, arg, wid, r32, hi);
    }
}
template <int NKS>
__device__ __forceinline__ void attn_h1_first(f32x16& p0, f32x16& p1, f32x16& negm, const bf16x8 (&qr)[NKS], const LAS unsigned char* kb, int bt, int wid, int r32, int hi, float shift) {
    const LAS unsigned char* ka = kb + hi * 1024 + r32 * 16;
    attn_qk<NKS>(p0, p1, negm, qr, ka);
    if (bt >= 0) attn_band_mask(p0, p1, bt, wid, r32, hi);
    asm volatile("s_nop 15\n\ts_nop 7" : "+v"(p0), "+v"(p1));
    float a = max3_s(p0[0], p0[1], p1[0]), b2 = max3_s(p0[2], p0[3], p1[1]);
    a = max3_s(a, p1[2], p1[3]);
#pragma unroll
    for (int r = 4; r < 16; r += 4) { a = max3_s(a, p0[r], p0[r + 1]); b2 = max3_s(b2, p0[r + 2], p0[r + 3]); a = max3_s(a, p1[r], p1[r + 1]); b2 = max3_s(b2, p1[r + 2], p1[r + 3]); }
    float rm = max2_s(a, b2);
    { auto rr = __builtin_amdgcn_permlane32_swap(__float_as_uint(rm), __float_as_uint(rm), false, false); rm = max2_s(__uint_as_float(rr[0]), __uint_as_float(rr[1])); }
    const float m0 = ((rm > -INFINITY) ? rm : 0.f) + shift;
#pragma unroll
    for (int r = 0; r < 16; ++r) { p0[r] -= m0; p1[r] -= m0; negm[r] = -m0; }
    asm volatile("" : "+v"(negm));
}
__device__ __forceinline__ void attn_h2(f32x16& p0, f32x16& p1, f32x16& o0, f32x16& o1, float& lrow, const LAS unsigned char* vb) {
    s16x4 vl[4], vh[4];
#pragma unroll
    for (int i = 0; i < 4; ++i) { vl[i] = vtr(vb + i * 1024); vh[i] = vtr(vb + i * 1024 + 512); }
    ATT_SBAR();
#pragma unroll
    for (int r = 0; r < 16; ++r) { p0[r] = __builtin_amdgcn_exp2f(p0[r]); p1[r] = __builtin_amdgcn_exp2f(p1[r]); }
    asm volatile("s_nop 1" : "+v"(p0), "+v"(p1));
    float s0 = add_s(p0[0], p0[1]), s1 = add_s(p1[0], p1[1]), s2 = add_s(p0[2], p0[3]), s3 = add_s(p1[2], p1[3]);
#pragma unroll
    for (int r = 4; r < 16; r += 4) { s0 = add_s(s0, p0[r]); s1 = add_s(s1, p1[r]); s2 = add_s(s2, p0[r + 2]); s3 = add_s(s3, p1[r + 2]);
        s0 = add_s(s0, p0[r + 1]); s1 = add_s(s1, p1[r + 1]); s2 = add_s(s2, p0[r + 3]); s3 = add_s(s3, p1[r + 3]); }
    lrow = add_s(lrow, add_s(add_s(s0, s1), add_s(s2, s3)));
    bf16x8 pw[4];
    { u32x4 w;
      w.x = cvtpk(p0[0], p0[1]); w.y = cvtpk(p0[2], p0[3]); w.z = cvtpk(p0[4], p0[5]); w.w = cvtpk(p0[6], p0[7]); pw[0] = __builtin_bit_cast(bf16x8, w);
      w.x = cvtpk(p0[8], p0[9]); w.y = cvtpk(p0[10], p0[11]); w.z = cvtpk(p0[12], p0[13]); w.w = cvtpk(p0[14], p0[15]); pw[1] = __builtin_bit_cast(bf16x8, w);
      w.x = cvtpk(p1[0], p1[1]); w.y = cvtpk(p1[2], p1[3]); w.z = cvtpk(p1[4], p1[5]); w.w = cvtpk(p1[6], p1[7]); pw[2] = __builtin_bit_cast(bf16x8, w);
      w.x = cvtpk(p1[8], p1[9]); w.y = cvtpk(p1[10], p1[11]); w.z = cvtpk(p1[12], p1[13]); w.w = cvtpk(p1[14], p1[15]); pw[3] = __builtin_bit_cast(bf16x8, w); }
    ATT_SBAR();
    s16x4 wl[4], wh[4];
#pragma unroll
    for (int i = 0; i < 4; ++i) { wl[i] = vtr(vb + 4096 + i * 1024); wh[i] = vtr(vb + 4096 + i * 1024 + 512); }
#pragma unroll
    for (int ks = 0; ks < 4; ++ks) {
        const bf16x8 va = (bf16x8){vl[ks][0], vl[ks][1], vl[ks][2], vl[ks][3], vh[ks][0], vh[ks][1], vh[ks][2], vh[ks][3]};
        o0 = __builtin_amdgcn_mfma_f32_32x32x16_bf16(va, pw[ks], o0, 0, 0, 0);
    }
#pragma unroll
    for (int ks = 0; ks < 4; ++ks) {
        const bf16x8 vb8 = (bf16x8){wl[ks][0], wl[ks][1], wl[ks][2], wl[ks][3], wh[ks][0], wh[ks][1], wh[ks][2], wh[ks][3]};
        o1 = __builtin_amdgcn_mfma_f32_32x32x16_bf16(vb8, pw[ks], o1, 0, 0, 0);
    }
    ATT_SBAR();
}

#ifndef ATT_SHIFT0
#define ATT_SHIFT0 0.0f
#endif
template <int DQK, bool MOBA>
__device__ __forceinline__ bool attn_unit(LAS unsigned char* lds, int b, int h, int qb, float shift,
                                          const bf16* __restrict__ Q, int ldq, const bf16* __restrict__ K, const bf16* __restrict__ KR,
                                          const bf16* __restrict__ V, const bf16* __restrict__ G, bf16* __restrict__ OG, const float* __restrict__ kmean) {
    constexpr int NKS = DQK / 16, NCH = DQK / 8, KBYTES = NCH * 1024, STG = KBYTES + 8192;
    int tid_ = threadIdx.x; asm volatile("" : "+v"(tid_));
    const int tid = tid_, lane = tid & 63, r32 = lane & 31, hi = lane >> 5;
    const int wid = __builtin_amdgcn_readfirstlane(tid >> 6);
    const bool grpB = wid >= 4;
    const size_t rowbase = (size_t)b * SEQ;
    const int q0 = qb * 256;
    const int NT = 4 * qb + 4;
#define TILE_OF(i) (MOBA ? (((i) < 4) ? 4 * qb + (i) : (i) - 4) : (i))
    const unsigned lds0 = (unsigned)(uintptr_t)lds;
    if (tid == 0) *(LAS unsigned*)(lds + 4 * STG) = 0u;
    const bf16* ksrc = K + (rowbase + lane) * 1024 + h * 64 + wid * 8;
    const bf16* vsrc = V + (rowbase + 16 * (wid & 3) + (lane >> 2)) * 1024 + h * 64 + (wid >> 2) * 32 + (lane & 3) * 8;
    const bf16* rsrc = (DQK == 96) ? KR + (rowbase + lane) * 32 + (wid & 3) * 8 : nullptr;
    const bool rope_w = (DQK == 96) && (wid < 4);
#define DMA_TILE(t_, stage_) do { const unsigned sb_ = lds0 + (stage_) * STG; \
        glds16(ksrc + (size_t)(t_) * 64 * 1024, (unsigned)__builtin_amdgcn_readfirstlane(sb_ + wid * 1024)); \
        if (rope_w) glds16(rsrc + (size_t)(t_) * 64 * 32, (unsigned)__builtin_amdgcn_readfirstlane(sb_ + (8 + wid) * 1024)); \
        glds16(vsrc + (size_t)(t_) * 64 * 1024, (unsigned)__builtin_amdgcn_readfirstlane(sb_ + KBYTES + wid * 1024)); } while (0)
#define STEP_DMA(i_) do { if ((i_) + 2 < NT) DMA_TILE(TILE_OF((i_) + 2), ((i_) + 2) & 3); } while (0)
#define STEP_WAIT(i_) do { if ((i_) + 2 < NT) { if (rope_w) ATT_WAIT_BAR(3); else ATT_WAIT_BAR(2); } else ATT_WAIT_BAR(0); } while (0)
    DMA_TILE(TILE_OF(0), 0);
    DMA_TILE(TILE_OF(1), 1);
    bf16x8 qr[NKS];
    {
        const bf16* qp = Q + (rowbase + q0 + wid * 32 + r32) * (size_t)ldq + h * DQK + hi * 8;
#pragma unroll
        for (int ks = 0; ks < NKS; ++ks) qr[ks] = *(const bf16x8*)(qp + ks * 16);
    }
    unsigned sel = 0u;
    if (MOBA) {
        float gs[7];
#pragma unroll
        for (int j = 0; j < 7; ++j) {
            float a = -INFINITY;
            if (j < qb) {
                const float* km = kmean + ((size_t)(b * NHEAD + h) * 8 + j) * 64 + hi * 8;
                float s = 0.f;
#pragma unroll
                for (int ks = 0; ks < NKS; ++ks) {
                    const f32x4 k0 = *(const f32x4*)(km + ks * 16), k1 = *(const f32x4*)(km + ks * 16 + 4);
                    s += bf2f(qr[ks][0]) * k0[0] + bf2f(qr[ks][1]) * k0[1] + bf2f(qr[ks][2]) * k0[2] + bf2f(qr[ks][3]) * k0[3];
                    s += bf2f(qr[ks][4]) * k1[0] + bf2f(qr[ks][5]) * k1[1] + bf2f(qr[ks][6]) * k1[2] + bf2f(qr[ks][7]) * k1[3];
                }
                a = s + __shfl_xor(s, 32);
            }
            gs[j] = a;
        }
#pragma unroll
        for (int k = 0; k < 3; ++k) {
            float best = -INFINITY; int bi = -1;
#pragma unroll
            for (int j = 0; j < 7; ++j) { const bool c = (((sel >> j) & 1u) == 0u) && (gs[j] > best); best = c ? gs[j] : best; bi = c ? j : bi; }
            if (bi >= 0) sel |= 1u << bi;
        }
    }
    const unsigned vread = KBYTES + ((lane >> 4) & 1) * 32 + (lane & 3) * 8 + (4 * hi + ((lane & 15) >> 2)) * 64;
    float lrow = 0.f;
    float zf = 0.f; asm volatile("" : "+v"(zf));
    f32x16 o0, o1, p0, p1, negm;
#pragma unroll
    for (int r = 0; r < 16; ++r) { o0[r] = zf; o1[r] = zf; p0[r] = zf; p1[r] = zf; negm[r] = zf; }
    asm volatile("" : "+v"(negm));
#pragma unroll
    for (int ks = 0; ks < NKS; ++ks) asm volatile("" :: "v"(qr[ks]));
    ATT_WAIT_BAR(0);
#define SB(i_) (lds + ((i_) & 3) * STG)
    STEP_DMA(0);
    attn_h1_first<NKS>(p0, p1, negm, qr, SB(0), (MOBA || qb == 0) ? 0 : -1, wid, r32, hi, shift);
    if (!grpB) attn_h2(p0, p1, o0, o1, lrow, SB(0) + vread);
    STEP_WAIT(0);
    const int seg = MOBA ? 4 : ((4 * qb > 1) ? 4 * qb : 1);
#define ATT_LOOP(I0, I1, MODE, ARG) do { \
        if (!grpB) { for (int i = (I0); i < (I1); ++i) { STEP_DMA(i); attn_h1<NKS, MODE>(p0, p1, negm, qr, SB(i), (ARG), wid, r32, hi, sel); attn_h2(p0, p1, o0, o1, lrow, SB(i) + vread); STEP_WAIT(i); } } \
        else { for (int i = (I0); i < (I1); ++i) { STEP_DMA(i); attn_h2(p0, p1, o0, o1, lrow, SB(i - 1) + vread); attn_h1<NKS, MODE>(p0, p1, negm, qr, SB(i), (ARG), wid, r32, hi, sel); STEP_WAIT(i); } } } while (0)
    if (MOBA) { ATT_LOOP(1, 4, 1, i); ATT_LOOP(4, NT, 2, (i - 4) >> 2); }
    else { ATT_LOOP(1, seg, 0, 0); ATT_LOOP(seg, NT, 1, i - 4 * qb); }
    if (grpB) attn_h2(p0, p1, o0, o1, lrow, SB(NT - 1) + vread);
    ATT_WAIT_BAR(0);
    lrow += __shfl_xor(lrow, 32);
    bool bad = !(lrow < 1.0e30f) || !(lrow > 0.f);
#pragma unroll
    for (int r = 0; r < 16; ++r) bad = bad || !(fabsf(o0[r]) < 1.0e36f) || !(fabsf(o1[r]) < 1.0e36f);
    const float inv = 1.0f / lrow;
    const bf16* gp = G + (rowbase + q0 + wid * 32 + r32) * 1024 + h * 64 + 4 * hi;
    bf16* op = OG + (rowbase + q0 + wid * 32 + r32) * 1024 + h * 64 + 4 * hi;
#pragma unroll
    for (int g = 0; g < 4; ++g) {
        const u32x2 g0 = *(const u32x2*)(gp + 8 * g), g1 = *(const u32x2*)(gp + 32 + 8 * g);
        u32x2 w0, w1;
        w0.x = cvtpk(o0[4 * g] * inv * __uint_as_float(g0.x << 16), o0[4 * g + 1] * inv * __uint_as_float(g0.x & 0xffff0000u));
        w0.y = cvtpk(o0[4 * g + 2] * inv * __uint_as_float(g0.y << 16), o0[4 * g + 3] * inv * __uint_as_float(g0.y & 0xffff0000u));
        w1.x = cvtpk(o1[4 * g] * inv * __uint_as_float(g1.x << 16), o1[4 * g + 1] * inv * __uint_as_float(g1.x & 0xffff0000u));
        w1.y = cvtpk(o1[4 * g + 2] * inv * __uint_as_float(g1.y << 16), o1[4 * g + 3] * inv * __uint_as_float(g1.y & 0xffff0000u));
        *(u32x2*)(op + 8 * g) = w0; *(u32x2*)(op + 32 + 8 * g) = w1;
    }
    if (__any(bad) && lane == 0) *(LAS unsigned*)(lds + 4 * STG) = 1u;
    __syncthreads();
    const unsigned again = *(LAS unsigned*)(lds + 4 * STG);
    __syncthreads();
    return again != 0u;
#undef DMA_TILE
#undef STEP_DMA
#undef STEP_WAIT
#undef SB
#undef ATT_LOOP
}
template <int DQK, bool MOBA>
__device__ __forceinline__ void attn_unit_checked(LAS unsigned char* lds, int b, int h, int qb, const bf16* Q, int ldq, const bf16* K, const bf16* KR, const bf16* V, const bf16* G, bf16* OG, const float* kmean) {
    float shift = ATT_SHIFT0;
    for (int tries = 0; tries < 6; ++tries) {
        if (!attn_unit<DQK, MOBA>(lds, b, h, qb, shift, Q, ldq, K, KR, V, G, OG, kmean)) break;
        shift += 90.0f;
    }
}
#undef TILE_OF

__device__ __forceinline__ int swap45(int d) { return (d & 15) | ((d & 16) << 1) | ((d & 32) >> 1); }
__device__ __forceinline__ void transpose_item(const float* __restrict__ W, int K, int Nsrc, bf16* WT, LAS float* scr, int k0, int n0, int srccol, const float* __restrict__ kscale, int lane) {
#pragma unroll 8
    for (int i = 0; i < 32; ++i) { const int kk = 2 * i + (lane >> 5);
        float v = (srccol >= 0) ? W[(size_t)(k0 + kk) * Nsrc + srccol] : 0.f;
        if (kscale) v *= kscale[k0 + kk];
        scr[kk * 33 + (lane & 31)] = v; }
    asm volatile("s_waitcnt lgkmcnt(0)" ::: "memory");
    const int c = lane & 7;
#pragma unroll
    for (int j = 0; j < 4; ++j) { const int n = (lane >> 3) + 8 * j; const LAS float* s = scr + (8 * c) * 33 + n;
        u32x4 o; o.x = pk2(s[0 * 33], s[1 * 33]); o.y = pk2(s[2 * 33], s[3 * 33]); o.z = pk2(s[4 * 33], s[5 * 33]); o.w = pk2(s[6 * 33], s[7 * 33]);
        *(u32x4*)(WT + (size_t)(n0 + n) * K + k0 + 8 * c) = o; }
    asm volatile("s_waitcnt lgkmcnt(0)" ::: "memory");
}

struct Args { const float* in[12]; float* out; unsigned char* ws; int ph_lo, ph_hi; };

__device__ __forceinline__ void prep_phase(const Args& a, LAS unsigned char* lds, int gw, int NGW, int wave, int lane) {
    unsigned char* ws = a.ws;
    LAS float* scr = (LAS float*)(lds + wave * 16384);
    const float* w_in = a.in[1]; const float* qn = a.in[2]; const float* kvn = a.in[3]; const float* w_uq = a.in[4]; const float* w_ukv = a.in[5]; const float* w_o = a.in[6];
    const float* w_kv = a.in[7]; const float* w_in2 = a.in[8]; const float* w_o2 = a.in[9];
    constexpr int I0 = 16 * 72, I1 = 12 * 48, I2 = 4 * 64, I3 = 16 * 32, I4 = 16 * 128, I5 = 16 * 32, NIT = I0 + I1 + I2 + I3 + I4 + I5;
    for (int it = gw; it < NIT; it += NGW) {
        int r = it; const int li = lane & 31;
        if (r < I0) { const int nb = r % 72, kb = r / 72, p = nb * 32 + li; const int sc = (p < 1024) ? p : (p < 2048) ? p + 32 : (p < 2080) ? p - 1024 : -1;
            transpose_item(w_in, 1024, 2080, (bf16*)(ws + WS_W1T), scr, kb * 64, nb * 32, sc, nullptr, lane); continue; } r -= I0;
        if (r < I1) { const int nb = r % 48, kb = r / 48; transpose_item(w_uq, 768, 1536, (bf16*)(ws + WS_WUQT), scr, kb * 64, nb * 32, nb * 32 + li, qn, lane); continue; } r -= I1;
        if (r < I2) { const int nb = r % 64, kb = r / 64, p = nb * 32 + li, pp = p & 1023; const int sc = (pp >> 6) * 128 + ((p >= 1024) ? 64 : 0) + (pp & 63);
            transpose_item(w_ukv, 256, 2048, (bf16*)(ws + WS_WUKVT), scr, kb * 64, nb * 32, sc, kvn, lane); continue; } r -= I2;
        if (r < I3) { const int nb = r % 32, kb = r / 32; transpose_item(w_o, 1024, 1024, (bf16*)(ws + WS_WOT), scr, kb * 64, nb * 32, nb * 32 + li, nullptr, lane); continue; } r -= I3;
        if (r < I4) { const int nb = r % 128, kb = r / 128, p = nb * 32 + li, sect = p >> 10, pp = p & 1023;
            const float* src = (sect < 2) ? w_kv : w_in2;
            const int sc = (sect == 0 || sect == 2) ? ((pp & ~63) | swap45(pp & 63)) : 1024 + pp;
            transpose_item(src, 1024, 2048, (bf16*)(ws + WS_W5T), scr, kb * 64, nb * 32, sc, nullptr, lane); continue; } r -= I4;
        { const int nb = r % 32, kb = r / 32; transpose_item(w_o2, 1024, 1024, (bf16*)(ws + WS_WO2T), scr, kb * 64, nb * 32, nb * 32 + li, nullptr, lane); }
    }
    {
        const float* x = a.in[0]; bf16* xb = (bf16*)(ws + WS_XB);
        const size_t gt = (size_t)gw * 64 + lane, NTH = (size_t)NGW * 64;
        for (size_t i = gt; i < (size_t)MT * DMODEL / 8; i += NTH) {
            const f32x4 v0 = *(const f32x4*)(x + i * 8), v1 = *(const f32x4*)(x + i * 8 + 4);
            u32x4 o; o.x = pk2(v0[0], v0[1]); o.y = pk2(v0[2], v0[3]); o.z = pk2(v1[0], v1[1]); o.w = pk2(v1[2], v1[3]);
            *(u32x4*)(xb + i * 8) = o;
        }
    }
    {
        float* tab = (float*)(ws + WS_TAB);
        const int gt = gw * 64 + lane, NTH = NGW * 64;
        for (int i = gt; i < 2048 * 48; i += NTH) {
            int pos, fi; float ex; float* cp; float* sp;
            if (i < 2048 * 16) { pos = i >> 4; fi = i & 15; ex = (float)(2 * fi) / 32.0f; cp = tab + i; sp = tab + 2048 * 16 + i; }
            else { const int j = i - 2048 * 16; pos = j >> 5; fi = j & 31; ex = (float)(2 * fi) / 64.0f; cp = tab + 2048 * 32 + j; sp = tab + 2048 * 32 + 2048 * 32 + j; }
            const float inv = __builtin_amdgcn_exp2f(-ex * 13.287712379549449f);
            const float ang = (float)pos * inv;
            const double rev = (double)ang * 0.15915494309189535; const double fr = rev - __builtin_floor(rev);
            *cp = __builtin_amdgcn_cosf((float)fr); *sp = __builtin_amdgcn_sinf((float)fr);
        }
    }
}

__device__ __forceinline__ void ln_phase(const float* z, float* outf, bf16* outb, const float* __restrict__ g, const float* __restrict__ bt, int gw, int NGW, int lane) {
    f32x4 gg[4], bb[4];
#pragma unroll
    for (int j = 0; j < 4; ++j) { gg[j] = *(const f32x4*)(g + 4 * lane + 256 * j); bb[j] = *(const f32x4*)(bt + 4 * lane + 256 * j); }
    for (int m = gw; m < MT; m += NGW) {
        const f32x4* xr = (const f32x4*)(z + (size_t)m * DMODEL) + lane;
        f32x4 v[4]; float s = 0.f;
#pragma unroll
        for (int j = 0; j < 4; ++j) { v[j] = xr[64 * j]; s += (v[j][0] + v[j][1]) + (v[j][2] + v[j][3]); }
        const float mean = wave_sum(s) * (1.f / DMODEL); float s2 = 0.f;
#pragma unroll
        for (int j = 0; j < 4; ++j) { v[j] = v[j] - mean; s2 += (v[j][0] * v[j][0] + v[j][1] * v[j][1]) + (v[j][2] * v[j][2] + v[j][3] * v[j][3]); }
        const float rstd = 1.f / sqrtf(wave_sum(s2) * (1.f / DMODEL) + 1e-5f);
        f32x4* orow = (f32x4*)(outf + (size_t)m * DMODEL) + lane;
#pragma unroll
        for (int j = 0; j < 4; ++j) { const f32x4 o = v[j] * rstd * gg[j] + bb[j]; orow[64 * j] = o;
            if (outb) { u32x2 w; w.x = pk2(o[0], o[1]); w.y = pk2(o[2], o[3]); *(u32x2*)(outb + (size_t)m * DMODEL + 4 * lane + 256 * j) = w; } }
    }
}

__device__ __forceinline__ void kmean_phase(const bf16* __restrict__ K, float* kmean, int gw, int NGW, int lane) {
    for (int it = gw; it < NB * 8 * NHEAD; it += NGW) {
        const int h = it & 15, blk = (it >> 4) & 7, b = it >> 7;
        const bf16* kp = K + ((size_t)b * SEQ + blk * 256 + (lane >> 3)) * 1024 + h * 64 + (lane & 7) * 8;
        float acc[8];
#pragma unroll
        for (int j = 0; j < 8; ++j) acc[j] = 0.f;
#pragma unroll 4
        for (int p = 0; p < 32; ++p) { const bf16x8 v = *(const bf16x8*)(kp + (size_t)p * 8 * 1024);
#pragma unroll
            for (int j = 0; j < 8; ++j) acc[j] += bf2f(v[j]); }
#pragma unroll
        for (int j = 0; j < 8; ++j) { float s = acc[j]; s += __shfl_xor(s, 8); s += __shfl_xor(s, 16); s += __shfl_xor(s, 32); acc[j] = s * (1.0f / 256.0f); }
        if (lane < 8) { float* o = kmean + ((size_t)(b * NHEAD + h) * 8 + blk) * 64 + lane * 8;
            *(f32x4*)o = (f32x4){acc[0], acc[1], acc[2], acc[3]}; *(f32x4*)(o + 4) = (f32x4){acc[4], acc[5], acc[6], acc[7]}; }
    }
}

#define XB_TMO      128
#define XB_XCNT(j)  (256  + 64 * (j))
#define XB_XSUB(j)  (1280 + 64 * (j))
#define XB_XGEN(j)  (2304 + 64 * (j))
#define XB_TOP      3328
#define XB_TOPGEN   3392
#define XCD_BAR_WORDS 3456
#define XB_SPIN_CAP (1u << 18)

__device__ __forceinline__ unsigned xb_ld(unsigned* p)              { return __hip_atomic_load(p, __ATOMIC_RELAXED, __HIP_MEMORY_SCOPE_AGENT); }
__device__ __forceinline__ unsigned xb_add(unsigned* p, unsigned v) { return __hip_atomic_fetch_add(p, v, __ATOMIC_RELAXED, __HIP_MEMORY_SCOPE_AGENT); }
__device__ __forceinline__ unsigned xb_xcc_id() { return (unsigned)__builtin_amdgcn_s_getreg((3 << 11) | 20) & 0xFu; }
#define XB_SPIN(cond, bar) do { unsigned _sp = 0; while (cond) { __builtin_amdgcn_s_sleep(1); \
    if ((++_sp & 255u) == 0u) { if (xb_ld(&(bar)[XB_TMO])) break; if (_sp > XB_SPIN_CAP) { atomicAdd(&(bar)[XB_TMO], 1u); break; } } } } while (0)

struct XcdBarrier {
    unsigned* bar; unsigned x;
    volatile LAS unsigned* st;
};

__device__ __forceinline__ XcdBarrier xcd_barrier_post(unsigned* bar, volatile LAS unsigned* st) {
    XcdBarrier b; b.bar = bar; b.x = xb_xcc_id(); b.st = st;
    if (threadIdx.x == 0) (void)xb_add(&bar[XB_XCNT(b.x)], 1u);
    return b;
}
__device__ __forceinline__ void xcd_barrier_complete(unsigned* bar, unsigned x, unsigned& nloc, unsigned& nx) {
    const unsigned G = gridDim.x * gridDim.y * gridDim.z;
    unsigned sum, cnt, mine, sp = 0u;
    for (;;) {
        sum = 0u; cnt = 0u; mine = 0u;
#pragma unroll
        for (unsigned j = 0; j < 16; ++j) { const unsigned c = xb_ld(&bar[XB_XCNT(j)]); sum += c; cnt += (c > 0u) ? 1u : 0u; mine = (j == x) ? c : mine; }
        if (sum == G) break;
        __builtin_amdgcn_s_sleep(1);
        if ((++sp & 255u) == 0u) { if (xb_ld(&bar[XB_TMO])) break; if (sp > XB_SPIN_CAP) { atomicAdd(&bar[XB_TMO], 1u); break; } }
    }
    nloc = mine > 0u ? mine : 1u; nx = cnt > 0u ? cnt : 1u;
}

__device__ __forceinline__ void xcd_barrier(const XcdBarrier& b) {
    asm volatile("s_waitcnt vmcnt(0)" ::: "memory");
    __syncthreads();
    if (threadIdx.x == 0) {
        unsigned* bar = b.bar;
        __builtin_amdgcn_s_waitcnt(0);
        unsigned nloc = b.st[0], nx = b.st[1];
        if (nloc == 0u) { xcd_barrier_complete(bar, b.x, nloc, nx); b.st[0] = nloc; b.st[1] = nx; }
        const unsigned old = xb_add(&bar[XB_XSUB(b.x)], 1u);
        const unsigned gen = old / nloc;
        if (old + 1u == (gen + 1u) * nloc) {
            __builtin_amdgcn_fence(__ATOMIC_RELEASE, "agent");
            asm volatile("s_waitcnt vmcnt(0)" ::: "memory");
            const unsigned og = xb_add(&bar[XB_TOP], 1u);
            const unsigned tg = og / nx;
            if (og + 1u == (tg + 1u) * nx) xb_add(&bar[XB_TOPGEN], 1u);
            else XB_SPIN(xb_ld(&bar[XB_TOPGEN]) == tg, bar);
            __builtin_amdgcn_fence(__ATOMIC_ACQUIRE, "agent");
            xb_add(&bar[XB_XGEN(b.x)], 1u);
            asm volatile("s_waitcnt vmcnt(0)" ::: "memory");
        } else {
            XB_SPIN(xb_ld(&bar[XB_XGEN(b.x)]) == gen, bar);
            __builtin_amdgcn_fence(__ATOMIC_ACQUIRE, "agent");
            asm volatile("s_waitcnt vmcnt(0)" ::: "memory");
        }
    }
    __syncthreads();
}

constexpr int NPHASE = 11;
__global__ void __launch_bounds__(NWAVES * 64, 2) mega_fwd(Args a) {
    extern __shared__ __attribute__((aligned(16))) unsigned char lds_raw[];
    LAS unsigned char* lds = (LAS unsigned char*)lds_raw;
    cg::grid_group grid = cg::this_grid();
    const int G = gridDim.x, bx = blockIdx.x;
    const int vcu = (G % 8 == 0) ? (bx % 8) * (G / 8) + bx / 8 : bx;
    const int NGW = G * NWAVES;
#define IDS() int tid_ = threadIdx.x; asm volatile("" : "+v"(tid_)); const int lane = tid_ & 63, wave = __builtin_amdgcn_readfirstlane(tid_ >> 6), gw = vcu * NWAVES + wave; (void)lane; (void)gw
    unsigned char* ws = a.ws;
#define W1T ((bf16*)(ws + WS_W1T))
#define WUQT ((bf16*)(ws + WS_WUQT))
#define WUKVT ((bf16*)(ws + WS_WUKVT))
#define WOT ((bf16*)(ws + WS_WOT))
#define W5T ((bf16*)(ws + WS_W5T))
#define WO2T ((bf16*)(ws + WS_WO2T))
#define cosA ((const float*)(ws + WS_TAB))
#define sinA ((const float*)(ws + WS_TAB) + 2048 * 16)
#define cosB ((const float*)(ws + WS_TAB) + 2048 * 32)
#define sinB ((const float*)(ws + WS_TAB) + 2048 * 64)
#define kmean ((float*)(ws + WS_KMEAN))
#define ssq ((float*)(ws + WS_SSQ))
#define KROPE ((bf16*)(ws + WS_KROPE))
#define XB ((bf16*)(ws + WS_XB))
#define CQ ((bf16*)(ws + WS_CQ))
#define CKV ((bf16*)(ws + WS_CKV))
#define GATE ((bf16*)(ws + WS_GATE))
#define QB ((bf16*)(ws + WS_Q))
#define KB ((bf16*)(ws + WS_K))
#define VB ((bf16*)(ws + WS_V))
    const int lo = a.ph_lo, hi = a.ph_hi;
#define IN(k) (lo <= (k) && (k) < hi)
    if (threadIdx.x < 2) ((volatile LAS unsigned*)(lds + LDS_BARST))[threadIdx.x] = 0u;
    __syncthreads();
    const XcdBarrier bar = xcd_barrier_post((unsigned*)(ws + WS_BAR), (volatile LAS unsigned*)(lds + LDS_BARST));
    if (lo < 0) grid.sync();
#define SEAM(k) do { if (IN(k) && IN((k) + 1)) xcd_barrier(bar); } while (0)

    if (IN(0)) { IDS(); prep_phase(a, lds, gw, NGW, wave, lane); }
    SEAM(0);
    if (IN(1)) {
        pg8::Gemm g{XB, W1T, MT, 2304, 1024}; pg8::StaticOrder S; S.init(MT, 2304, G, bx);
        pg8::Epi1 E{CQ, CKV, GATE, KROPE, ssq, cosA, sinA};
        pg8::gemm_phase<pg8::Epi1, pg8::StaticOrder, true, true>(lds, g, S, E);
    }
    SEAM(1);
    if (IN(2)) {
        { pg8::Gemm g{CQ, WUQT, MT, 1536, 768}; pg8::StaticOrder S; S.init(MT, 1536, G, bx);
          pg8::Epi2 E{QB, ssq, cosA, sinA, QS_A};
          pg8::gemm_phase<pg8::Epi2, pg8::StaticOrder, true, true>(lds, g, S, E); }
        { pg8::Gemm g{CKV, WUKVT, MT, 2048, 256}; pg8::StaticOrder S; S.init(MT, 2048, G, bx);
          pg8::Epi3 E{KB, VB, ssq};
          pg8::gemm_phase<pg8::Epi3, pg8::StaticOrder, true, true>(lds, g, S, E); }
    }
    SEAM(2);
    if (IN(3)) {
        for (int U = vcu; U < 2048; U += G) { const int v = U & 255, k = U >> 8, xg = v >> 3, j = v & 7, bh = (xg >> 2) * 32 + 4 * k + (xg & 3);
            attn_unit_checked<96, false>(lds, bh >> 4, bh & 15, (j + k) & 7, QB, 1536, KB, KROPE, VB, GATE, CQ, nullptr); }
    }
    SEAM(3);
    if (IN(4)) {
        pg8::Gemm g{CQ, WOT, MT, 1024, 1024}; pg8::StaticOrder S; S.init(MT, 1024, G, bx);
        pg8::Epi4 E{a.in[0], a.out, ALPHA};
        pg8::gemm_phase<pg8::Epi4, pg8::StaticOrder, true, true>(lds, g, S, E);
    }
    SEAM(4);
    if (IN(5)) { IDS(); ln_phase(a.out, a.out, XB, a.in[10], a.in[11], gw, NGW, lane); }
    SEAM(5);
    if (IN(6)) {
        pg8::Gemm g{XB, W5T, MT, 4096, 1024}; pg8::StaticOrder S; S.init(MT, 4096, G, bx);
        pg8::Epi5 E{KB, VB, QB, GATE, cosB, sinB, QS_B};
        pg8::gemm_phase<pg8::Epi5, pg8::StaticOrder, true, true>(lds, g, S, E);
    }
    SEAM(6);
    if (IN(7)) { IDS(); kmean_phase(KB, kmean, gw, NGW, lane); }
    SEAM(7);
    if (IN(8)) {
        for (int U = vcu; U < 2048; U += G) { const int v = U & 255, k = U >> 8, xg = v >> 3, j = v & 7, bh = (xg >> 2) * 32 + 4 * k + (xg & 3);
            attn_unit_checked<64, true>(lds, bh >> 4, bh & 15, (j + k) & 7, QB, 1024, KB, nullptr, VB, GATE, XB, kmean); }
    }
    SEAM(8);
    if (IN(9)) {
        pg8::Gemm g{XB, WO2T, MT, 1024, 1024}; pg8::StaticOrder S; S.init(MT, 1024, G, bx);
        pg8::Epi4 E{a.out, a.out, ALPHA};
        pg8::gemm_phase<pg8::Epi4, pg8::StaticOrder, true, true>(lds, g, S, E);
    }
    SEAM(9);
    if (IN(10)) { IDS(); ln_phase(a.out, a.out, nullptr, a.in[10] + 1024, a.in[11] + 1024, gw, NGW, lane); }
#undef IN
#undef SEAM
}

#ifndef MK_PER_PHASE
#define MK_PER_PHASE 0
#endif
extern "C" void kernel_launch(void* const* d_in, const int* in_sizes, int n_in, void* d_out, int out_size, void* d_ws, size_t ws_size, hipStream_t stream) {
    static int grid = 0;
    if (grid == 0) {
        if (n_in != 12 || out_size != MT * DMODEL || ws_size < WS_END) { fprintf(stderr, "kernel_launch: unexpected shapes (n_in %d out %d ws %zu)\n", n_in, out_size, ws_size); grid = -1; return; }
        int dev = 0, cus = 0, per_cu = 0;
        (void)hipGetDevice(&dev); (void)hipDeviceGetAttribute(&cus, hipDeviceAttributeMultiprocessorCount, dev);
        if (hipFuncSetAttribute((const void*)mega_fwd, hipFuncAttributeMaxDynamicSharedMemorySize, LDS_BYTES) != hipSuccess) { fprintf(stderr, "hipFuncSetAttribute failed\n"); grid = -1; return; }
        if (hipOccupancyMaxActiveBlocksPerMultiprocessor(&per_cu, (const void*)mega_fwd, NWAVES * 64, LDS_BYTES) != hipSuccess || per_cu < 1) { fprintf(stderr, "occupancy query: %d\n", per_cu); per_cu = 1; }
        (void)hipGetLastError();
        grid = cus;
    }
    if (grid < 0) return;
    if (hipMemsetAsync((char*)d_ws + WS_BAR, 0, BAR_BYTES, stream) != hipSuccess) { fprintf(stderr, "kernel_launch: memset of the barrier words failed\n"); return; }
    Args a{};
    for (int i = 0; i < 12; ++i) a.in[i] = (const float*)d_in[i];
    a.out = (float*)d_out; a.ws = (unsigned char*)d_ws;
#if MK_PER_PHASE
    for (int p = 0; p < NPHASE; ++p) { a.ph_lo = p; a.ph_hi = p + 1; hipLaunchKernelGGL(mega_fwd, dim3(grid), dim3(NWAVES * 64), LDS_BYTES, stream, a); }
#else
    a.ph_lo = 0; a.ph_hi = NPHASE;
    void* args[] = {&a};
    hipError_t e = hipLaunchCooperativeKernel((const void*)mega_fwd, dim3(grid), dim3(NWAVES * 64), args, LDS_BYTES, stream);
    if (e != hipSuccess) fprintf(stderr, "cooperative launch failed: %s (grid %d)\n", hipGetErrorString(e), grid);
#ifdef PROBE_RERUN
    { const int pr[] = {PROBE_RERUN}; for (int p : pr) { a.ph_lo = p; a.ph_hi = p + 1; hipLaunchKernelGGL(mega_fwd, dim3(grid), dim3(NWAVES * 64), LDS_BYTES, stream, a); } }
#endif
#endif
}
```
